# Optimizing an MI355X kernel written in HIP

```python
import jax, jax.numpy as jnp
from jax import lax
import numpy as np

D_MODEL = 1024
BATCH = 8
SEQ = 4096
DEPTH = 4

N_MIXERS = 4
EPS = 1e-6
A_CHUNK = 128
A_WIDTH = 2048
A_GROUPS = 4
B_WIDTH = 1024
B_WINDOWS = (2, 4, 8, 16)
B_GROUPS = 4
C_WIDTH = 1024
C_HEADS = 4
C_CONV = 4
C_GATE_C = 8.0
D_WIDTH = 1024
D_CONV = 3
FFN_WIDTH = 2816
FFN_CONV = 3

kernel_name = "hybrid_interleaved_gmlp_pool_rglru_shortconv"


def rms_norm(x, g):
    xf = x.astype(jnp.float32)
    y = xf * lax.rsqrt(jnp.mean(xf * xf, axis=-1, keepdims=True) + EPS)
    return (y * g.astype(jnp.float32)).astype(x.dtype)


def causal_dwconv(x, w):
    k_taps = w.shape[0]
    s = x.shape[1]
    xp = jnp.pad(x, ((0, 0), (k_taps - 1, 0), (0, 0)))
    y = xp[:, 0:s] * w[0]
    for k in range(1, k_taps):
        y = y + xp[:, k:k + s] * w[k]
    return y


def mixer_gmlp(h, w_in, b_in, v_norm_g, w_s, b_s, w_out):
    bsz, s, _ = h.shape
    z = jax.nn.gelu(h @ w_in + b_in)
    u, v = jnp.split(z, 2, axis=-1)
    v = rms_norm(v, v_norm_g)
    gw = A_WIDTH // A_GROUPS
    v = v.reshape(bsz, s // A_CHUNK, A_CHUNK, A_GROUPS, gw)
    mask = jnp.tril(jnp.ones((A_CHUNK, A_CHUNK), dtype=bool))
    ws = jnp.where(mask, w_s, jnp.zeros_like(w_s))
    v = jnp.einsum('gts,bcsgd->bctgd', ws, v) + b_s.T[:, :, None]
    v = v.reshape(bsz, s, A_WIDTH)
    return (u * v) @ w_out


def mixer_pool(h, w_in, w_grp, b_grp, scale, w_out):
    bsz, s, _ = h.shape
    z = h @ w_in
    gw = B_WIDTH // B_GROUPS
    zf = z.astype(jnp.float32)
    csum = jnp.pad(jnp.cumsum(zf, axis=1), ((0, 0), (1, 0), (0, 0)))
    pos = jnp.arange(s)
    pooled = []
    for gi, win in enumerate(B_WINDOWS):
        c = csum[..., gi * gw:(gi + 1) * gw]
        upper = c[:, 1:]
        lower = jnp.pad(c[:, :s + 1 - win], ((0, 0), (win - 1, 0), (0, 0)))
        cnt = jnp.minimum(pos + 1, win).astype(jnp.float32)
        pooled.append((upper - lower) / cnt[None, :, None])
    p = (jnp.concatenate(pooled, axis=-1) - zf).astype(z.dtype)
    p = p.reshape(bsz, s, B_GROUPS, gw)
    y = jnp.einsum('bsgd,gde->bsge', p, w_grp) + b_grp
    y = y.reshape(bsz, s, B_WIDTH) * scale
    return y @ w_out


def mixer_rglru(h, w_in, b_in, conv_w, conv_b, w_a, b_a, w_i, b_i, lam, w_out):
    bsz, s, _ = h.shape
    z = h @ w_in + b_in
    gate, xr = jnp.split(z, 2, axis=-1)
    gate = jax.nn.gelu(gate)
    xr = causal_dwconv(xr, conv_w) + conv_b
    hw = C_WIDTH // C_HEADS
    xh = xr.reshape(bsz, s, C_HEADS, hw)
    r = jax.nn.sigmoid(jnp.einsum('bshd,hde->bshe', xh, w_a) + b_a).reshape(bsz, s, C_WIDTH)
    ig = jax.nn.sigmoid(jnp.einsum('bshd,hde->bshe', xh, w_i) + b_i).reshape(bsz, s, C_WIDTH)
    log_a = (-C_GATE_C * r.astype(jnp.float32)) * jax.nn.softplus(-lam.astype(jnp.float32))
    a = jnp.exp(log_a)
    mult = jnp.sqrt(-jnp.expm1(2.0 * log_a))
    bterm = mult * (ig * xr).astype(jnp.float32)

    def combine(left, right):
        a1, b1 = left
        a2, b2 = right
        return a1 * a2, a2 * b1 + b2

    _, hs = lax.associative_scan(combine, (a, bterm), axis=1)
    y = hs.astype(h.dtype) * gate
    return y @ w_out


def mixer_shortconv(h, w_in, conv_w, w_out):
    z = h @ w_in
    b_gate, c_gate, xv = jnp.split(z, 3, axis=-1)
    y = b_gate * causal_dwconv(c_gate * xv, conv_w)
    return y @ w_out


def conv_ffn(h, w_up, conv_w, conv_b, w_down):
    z = causal_dwconv(h @ w_up, conv_w) + conv_b
    g, v = jnp.split(z, 2, axis=-1)
    return (jax.nn.silu(g) * v) @ w_down


def setup_inputs(seed: int = 0) -> dict:
    key = jax.random.key(seed)
    keys = iter(jax.random.split(key, 64))
    n_a, n_b, n_c, n_d = (len(range(m, DEPTH, N_MIXERS)) for m in range(N_MIXERS))
    d = D_MODEL

    def nrm(shape, scale):
        return scale * jax.random.normal(next(keys), shape, jnp.float32)

    def gain(shape):
        return 1.0 + nrm(shape, 0.02)

    inp = {}
    inp["x"] = nrm((BATCH, SEQ, d), 1.0)
    inp["a_norm_g"] = gain((n_a, d))
    inp["a_w_in"] = nrm((n_a, d, 2 * A_WIDTH), d ** -0.5)
    inp["a_b_in"] = nrm((n_a, 2 * A_WIDTH), 0.02)
    inp["a_v_norm_g"] = gain((n_a, A_WIDTH))
    inp["a_w_s"] = nrm((n_a, A_GROUPS, A_CHUNK, A_CHUNK), A_CHUNK ** -0.5)
    inp["a_b_s"] = 1.0 + nrm((n_a, A_GROUPS, A_CHUNK), 0.1)
    inp["a_w_out"] = nrm((n_a, A_WIDTH, d), 0.5 * A_WIDTH ** -0.5)
    gwb = B_WIDTH // B_GROUPS
    inp["b_norm_g"] = gain((n_b, d))
    inp["b_w_in"] = nrm((n_b, d, B_WIDTH), d ** -0.5)
    inp["b_w_grp"] = nrm((n_b, B_GROUPS, gwb, gwb), gwb ** -0.5)
    inp["b_b_grp"] = nrm((n_b, B_GROUPS, gwb), 0.02)
    inp["b_scale"] = 1.0 + nrm((n_b, B_WIDTH), 0.1)
    inp["b_w_out"] = nrm((n_b, B_WIDTH, d), 0.5 * B_WIDTH ** -0.5)
    hwc = C_WIDTH // C_HEADS
    inp["c_norm_g"] = gain((n_c, d))
    inp["c_w_in"] = nrm((n_c, d, 2 * C_WIDTH), d ** -0.5)
    inp["c_b_in"] = nrm((n_c, 2 * C_WIDTH), 0.02)
    inp["c_conv_w"] = nrm((n_c, C_CONV, C_WIDTH), C_CONV ** -0.5)
    inp["c_conv_b"] = nrm((n_c, C_WIDTH), 0.02)
    inp["c_w_a"] = nrm((n_c, C_HEADS, hwc, hwc), hwc ** -0.5)
    inp["c_b_a"] = nrm((n_c, C_HEADS, hwc), 0.02)
    inp["c_w_i"] = nrm((n_c, C_HEADS, hwc, hwc), hwc ** -0.5)
    inp["c_b_i"] = nrm((n_c, C_HEADS, hwc), 0.02)
    u = jax.random.uniform(next(keys), (n_c, C_WIDTH), jnp.float32, minval=0.9, maxval=0.999)
    sgm = u ** (1.0 / C_GATE_C)
    inp["c_lambda"] = jnp.log(sgm) - jnp.log1p(-sgm)
    inp["c_w_out"] = nrm((n_c, C_WIDTH, d), C_WIDTH ** -0.5)
    inp["d_norm_g"] = gain((n_d, d))
    inp["d_w_in"] = nrm((n_d, d, 3 * D_WIDTH), d ** -0.5)
    inp["d_conv_w"] = nrm((n_d, D_CONV, D_WIDTH), D_CONV ** -0.5)
    inp["d_w_out"] = nrm((n_d, D_WIDTH, d), 0.5 * D_WIDTH ** -0.5)
    inp["ffn_norm_g"] = gain((DEPTH, d))
    inp["ffn_w_up"] = nrm((DEPTH, d, 2 * FFN_WIDTH), d ** -0.5)
    inp["ffn_conv_w"] = nrm((DEPTH, FFN_CONV, 2 * FFN_WIDTH), FFN_CONV ** -0.5)
    inp["ffn_conv_b"] = nrm((DEPTH, 2 * FFN_WIDTH), 0.02)
    inp["ffn_w_down"] = nrm((DEPTH, FFN_WIDTH, d), FFN_WIDTH ** -0.5)
    inp["final_norm_g"] = gain((d,))
    return inp


def reference(x,
              a_norm_g, a_w_in, a_b_in, a_v_norm_g, a_w_s, a_b_s, a_w_out,
              b_norm_g, b_w_in, b_w_grp, b_b_grp, b_scale, b_w_out,
              c_norm_g, c_w_in, c_b_in, c_conv_w, c_conv_b, c_w_a, c_b_a, c_w_i, c_b_i, c_lambda, c_w_out,
              d_norm_g, d_w_in, d_conv_w, d_w_out,
              ffn_norm_g, ffn_w_up, ffn_conv_w, ffn_conv_b, ffn_w_down,
              final_norm_g):
    for layer in range(DEPTH):
        m, j = layer % N_MIXERS, layer // N_MIXERS
        if m == 0:
            x = x + mixer_gmlp(rms_norm(x, a_norm_g[j]), a_w_in[j], a_b_in[j], a_v_norm_g[j],
                               a_w_s[j], a_b_s[j], a_w_out[j])
        elif m == 1:
            x = x + mixer_pool(rms_norm(x, b_norm_g[j]), b_w_in[j], b_w_grp[j], b_b_grp[j],
                               b_scale[j], b_w_out[j])
        elif m == 2:
            x = x + mixer_rglru(rms_norm(x, c_norm_g[j]), c_w_in[j], c_b_in[j], c_conv_w[j], c_conv_b[j],
                                c_w_a[j], c_b_a[j], c_w_i[j], c_b_i[j], c_lambda[j], c_w_out[j])
        else:
            x = x + mixer_shortconv(rms_norm(x, d_norm_g[j]), d_w_in[j], d_conv_w[j], d_w_out[j])
        x = x + conv_ffn(rms_norm(x, ffn_norm_g[layer]), ffn_w_up[layer], ffn_conv_w[layer],
                         ffn_conv_b[layer], ffn_w_down[layer])
    return rms_norm(x, final_norm_g)
```

```cpp
#include <hip/hip_runtime.h>
#include <hip/hip_cooperative_groups.h>
#include <cstdio>
#include <cstdint>
namespace cg = cooperative_groups;

#define LAS __attribute__((address_space(3)))
typedef unsigned short bf16_t;
typedef short bf16x8 __attribute__((ext_vector_type(8)));
typedef float f32x4 __attribute__((ext_vector_type(4)));
typedef unsigned u32x4 __attribute__((ext_vector_type(4)));
typedef unsigned u32x2 __attribute__((ext_vector_type(2)));
typedef float f32x2v __attribute__((ext_vector_type(2)));

constexpr int M = 32768, D = 1024, SEQ = 4096;
constexpr int FFW = 2816;
constexpr float EPS = 1e-6f;
constexpr int NTHREADS = 512;
#ifndef FFN_WGM
#define FFN_WGM 4
#endif
constexpr int LDS_BYTES = 147456;
constexpr size_t MiB = 1u << 20;

constexpr size_t WS_SS = 0;
constexpr size_t WS_SSV = 18 * MiB;
constexpr size_t WS_SCAN = 22 * MiB;
constexpr size_t WS_W = 26 * MiB;
constexpr size_t WS_XB = 124 * MiB;
constexpr size_t WS_ARENA = 188 * MiB;
constexpr size_t WS_BAR = 123 * MiB + 768 * 1024;
constexpr size_t WS_NEED = 512 * MiB;

constexpr size_t O_A_IN = 0;
constexpr size_t O_A_OUT = O_A_IN + (size_t)4096 * 1024;
constexpr size_t O_B_IN = O_A_OUT + (size_t)1024 * 2048;
constexpr size_t O_B_GRP = O_B_IN + (size_t)1024 * 1024;
constexpr size_t O_B_OUT = O_B_GRP + (size_t)4 * 256 * 256;
constexpr size_t O_C_IN = O_B_OUT + (size_t)1024 * 1024;
constexpr size_t O_C_GATE = O_C_IN + (size_t)2048 * 1024;
constexpr size_t O_C_OUT = O_C_GATE + (size_t)2048 * 256;
constexpr size_t O_D_IN = O_C_OUT + (size_t)1024 * 1024;
constexpr size_t O_D_OUT = O_D_IN + (size_t)3072 * 1024;
constexpr size_t O_F = O_D_OUT + (size_t)1024 * 1024;
constexpr size_t F_UP_SZ = (size_t)5632 * 1024, F_DN_SZ = (size_t)1024 * 2816;
constexpr size_t O_END = O_F + 4 * (F_UP_SZ + F_DN_SZ);
static_assert(WS_W + O_END * 2 <= WS_BAR && WS_BAR + 16384 <= WS_XB, "weights fit");

struct Params { const float* in[35]; float* out; unsigned char* ws; };

__device__ __forceinline__ unsigned cvt_pk_bf16(float lo, float hi) { unsigned r; asm("v_cvt_pk_bf16_f32 %0, %1, %2" : "=v"(r) : "v"(lo), "v"(hi)); return r; }
__device__ __forceinline__ float bf_lo(unsigned w) { return __uint_as_float(w << 16); }
__device__ __forceinline__ float bf_hi(unsigned w) { return __uint_as_float(w & 0xffff0000u); }
__device__ __forceinline__ void unpack8(const u32x4 w, float (&f)[8]) { f[0] = bf_lo(w.x); f[1] = bf_hi(w.x); f[2] = bf_lo(w.y); f[3] = bf_hi(w.y); f[4] = bf_lo(w.z); f[5] = bf_hi(w.z); f[6] = bf_lo(w.w); f[7] = bf_hi(w.w); }
__device__ __forceinline__ u32x4 pack8(const float (&f)[8]) { u32x4 w; w.x = cvt_pk_bf16(f[0], f[1]); w.y = cvt_pk_bf16(f[2], f[3]); w.z = cvt_pk_bf16(f[4], f[5]); w.w = cvt_pk_bf16(f[6], f[7]); return w; }
__device__ __forceinline__ float sigmoidf_(float x) { return 1.0f / (1.0f + __expf(-x)); }
__device__ __forceinline__ float gelu_tanh(float x) { const float u = 1.5957691216057308f * (x + 0.044715f * x * x * x); return x * sigmoidf_(u); }
__device__ __forceinline__ float siluf_(float x) { return x * sigmoidf_(x); }
__device__ __forceinline__ f32x2v gelu_tanh_pk(f32x2v x) {
    const f32x2v x2 = x * x, u = x * (x2 * 0.044715f + 1.0f), e = u * (-2.3022082f);
    f32x2v t; t.x = __builtin_amdgcn_exp2f(e.x); t.y = __builtin_amdgcn_exp2f(e.y);
    const f32x2v d = t + 1.0f; f32x2v r; r.x = __builtin_amdgcn_rcpf(d.x); r.y = __builtin_amdgcn_rcpf(d.y);
    return x * r; }
__device__ __forceinline__ unsigned pack_f16(float lo, float hi) { const _Float16 a = (_Float16)lo, b = (_Float16)hi; return (unsigned)__builtin_bit_cast(unsigned short, a) | ((unsigned)__builtin_bit_cast(unsigned short, b) << 16); }
__device__ __forceinline__ float f16_lo(unsigned w) { return (float)__builtin_bit_cast(_Float16, (unsigned short)(w & 0xffffu)); }
__device__ __forceinline__ float f16_hi(unsigned w) { return (float)__builtin_bit_cast(_Float16, (unsigned short)(w >> 16)); }
__device__ __forceinline__ int lane_id_hw() { int l; asm volatile("v_mbcnt_lo_u32_b32 %0, -1, 0\n\tv_mbcnt_hi_u32_b32 %0, -1, %0" : "=v"(l)); return l; }
__device__ __forceinline__ float wave_sum(float v) {
#pragma unroll
    for (int o = 1; o < 64; o <<= 1) v += __shfl_xor(v, o);
    return v;
}

__device__ __forceinline__ float sum16(const float* p) { const f32x4 a = *(const f32x4*)p, b = *(const f32x4*)(p + 4), c = *(const f32x4*)(p + 8), d = *(const f32x4*)(p + 12);
    return ((a[0] + a[1]) + (a[2] + a[3])) + ((b[0] + b[1]) + (b[2] + b[3])) + (((c[0] + c[1]) + (c[2] + c[3])) + ((d[0] + d[1]) + (d[2] + d[3]))); }

__device__ __forceinline__ void conv4_item(const bf16_t* XR, bf16_t* XRc, const float* cw, const float* cb, int row, int c, int tlim) {
    float a[8];
    { const f32x4 b0 = *(const f32x4*)(cb + c), b1 = *(const f32x4*)(cb + c + 4);
#pragma unroll
      for (int j = 0; j < 4; ++j) { a[j] = b0[j]; a[4 + j] = b1[j]; } }
#pragma unroll
    for (int k = 0; k < 4; ++k) { const int dt = 3 - k; if (tlim >= dt) { float z[8]; unpack8(*(const u32x4*)(XR + (size_t)(row - dt) * D + c), z);
        const f32x4 w0 = *(const f32x4*)(cw + k * 1024 + c), w1 = *(const f32x4*)(cw + k * 1024 + c + 4);
#pragma unroll
        for (int j = 0; j < 4; ++j) { a[j] += w0[j] * z[j]; a[4 + j] += w1[j] * z[4 + j]; } } }
    *(u32x4*)(XRc + (size_t)row * D + c) = pack8(a);
}
__device__ __forceinline__ void shortconv_item(const bf16_t* Z, bf16_t* Y, const float* cw, int row, int c, int tlim) {
    float a[8];
#pragma unroll
    for (int j = 0; j < 8; ++j) a[j] = 0.f;
#pragma unroll
    for (int k = 0; k < 3; ++k) { const int dt = 2 - k; if (tlim >= dt) { const bf16_t* zp = Z + (size_t)(row - dt) * 3072 + c; float cgv[8], xv[8]; unpack8(*(const u32x4*)(zp + 1024), cgv); unpack8(*(const u32x4*)(zp + 2048), xv);
        const f32x4 w0 = *(const f32x4*)(cw + k * 1024 + c), w1 = *(const f32x4*)(cw + k * 1024 + c + 4);
#pragma unroll
        for (int j = 0; j < 4; ++j) { a[j] += w0[j] * (cgv[j] * xv[j]); a[4 + j] += w1[j] * (cgv[4 + j] * xv[4 + j]); } } }
    float bg[8]; unpack8(*(const u32x4*)(Z + (size_t)row * 3072 + c), bg);
#pragma unroll
    for (int j = 0; j < 8; ++j) a[j] *= bg[j];
    *(u32x4*)(Y + (size_t)row * D + c) = pack8(a);
}

__device__ __forceinline__ void pool_item(const bf16_t* Z, bf16_t* P, int row, int c, int win, int tseq) {
    const int cnt = (tseq + 1 < win) ? tseq + 1 : win;
    float s[8], z0[8];
    unpack8(*(const u32x4*)(Z + (size_t)row * D + c), z0);
#pragma unroll
    for (int j = 0; j < 8; ++j) s[j] = z0[j];
    for (int i = 1; i < cnt; ++i) { float z[8]; unpack8(*(const u32x4*)(Z + (size_t)(row - i) * D + c), z);
#pragma unroll
        for (int j = 0; j < 8; ++j) s[j] += z[j]; }
    const float inv = 1.0f / (float)cnt; float o[8];
#pragma unroll
    for (int j = 0; j < 8; ++j) o[j] = s[j] * inv - z0[j];
    *(u32x4*)(P + (size_t)row * D + c) = pack8(o);
}
template <int WIN>
__device__ __forceinline__ void pool_post(const bf16_t* zb, bf16_t* yb, int rb) {
    u32x4 zv[16 + WIN - 1];
    if (rb > 0) {
#pragma unroll
        for (int i = 0; i < WIN - 1; ++i) zv[i] = *(const u32x4*)(zb + (ptrdiff_t)(i - (WIN - 1)) * D); }
#pragma unroll
    for (int i = 0; i < 16; ++i) zv[WIN - 1 + i] = *(const u32x4*)(zb + (size_t)i * D);
    float S[8];
#pragma unroll
    for (int j = 0; j < 8; ++j) S[j] = 0.f;
    if (rb > 0) {
#pragma unroll
        for (int i = 0; i < WIN - 1; ++i) { float z[8]; unpack8(zv[i], z);
#pragma unroll
            for (int j = 0; j < 8; ++j) S[j] += z[j]; } }
#pragma unroll
    for (int r = 0; r < 16; ++r) { float z[8], o[8]; unpack8(zv[WIN - 1 + r], z);
        const float inv = (rb > 0 || r + 1 >= WIN) ? (1.0f / (float)WIN) : (1.0f / (float)(r + 1));
#pragma unroll
        for (int j = 0; j < 8; ++j) { S[j] += z[j]; o[j] = S[j] * inv - z[j]; }
        *(u32x4*)(yb + (size_t)r * D) = pack8(o);
        if (rb > 0 || r + 1 >= WIN) { float zo[8]; unpack8(zv[r], zo);
#pragma unroll
            for (int j = 0; j < 8; ++j) S[j] -= zo[j]; } }
}

namespace pg8 {
constexpr int BM = 256, BK = 64, HALF = 128, HTB = HALF * BK * 2, STAGE_BYTES = 8 * HTB, NXCD = 8, WGM = 8;
__device__ __forceinline__ int lds_byte(int r, int c) { const int st = (r >> 4) * 2 + (c >> 5), rr = r & 15, cc = c & 31, ob = rr * 64 + cc * 2; return st * 1024 + (ob ^ (((ob >> 9) & 1) << 5)); }
__device__ __forceinline__ void stage_rc(int b, int& R, int& C) { const int st = b / 1024, sb = b % 1024, swz = sb ^ (((sb >> 9) & 1) << 5); R = (st >> 1) * 16 + swz / 64; C = (st & 1) * 32 + (swz % 64) / 2; }
__device__ __forceinline__ int perm32(int rho) { const int n = rho >> 4, i = rho & 15; return 8 * (i >> 2) + 4 * n + (i & 3); }

struct Unit { int pm, pn; };
struct Gemm { const bf16_t* A; const bf16_t* Bt; int lda, K, nM, nN, ashift, astep; };

struct StaticOrder {
    int nM, nN, nwg, G, c, wgm;
    __device__ void init(int nM_, int nN_, int G_, int c_, int wgm_ = WGM) { nM = nM_; nN = nN_; nwg = nM * nN; G = G_; c = c_; wgm = wgm_; }
    __device__ bool next(int i, Unit& u) const {
        const long L = (long)i * G + c; if (L >= nwg) return false;
        int wgid = (int)L; { const int q = nwg / NXCD, r = nwg % NXCD, xcd = wgid % NXCD, off = wgid / NXCD; wgid = (xcd < r ? xcd * (q + 1) : r * (q + 1) + (xcd - r) * q) + off; }
        const int nig = wgm * nN, gid = wgid / nig, fm = gid * wgm, gsz = (nM - fm) < wgm ? (nM - fm) : wgm;
        u.pm = fm + ((wgid % nig) % gsz); u.pn = (wgid % nig) / gsz; return true;
    }
};

template <class Epi>
__device__ __forceinline__ void gemm_phase(LAS unsigned char* lds, const Gemm g, const StaticOrder& S, const Epi& E, const int tid) {
    const int wid = __builtin_amdgcn_readfirstlane(tid >> 6), lane = tid & 63, wr = wid >> 2, wc = wid & 3, fr = lane & 15, fq = lane >> 4;
    int K = g.K, lda = g.lda; asm volatile("" : "+s"(K), "+s"(lda));
    const int nt = K / BK;
    unsigned voffA[2], voffB[2];
#pragma unroll
    for (int i = 0; i < 2; ++i) { int R, C; stage_rc(tid * 16 + i * 8192, R, C); const int Rb = Epi::PERM ? ((R & ~31) + perm32(R & 31)) : R;
        voffA[i] = (unsigned)(R * lda + C) * 2u; voffB[i] = (unsigned)(Rb * K + C) * 2u; }
    const size_t kstep = (size_t)(BK * 2);
    const size_t hstepA = (size_t)HALF * lda * 2, hstepB = (size_t)HALF * K * 2;
    const size_t tstepA = 2 * hstepA, tstepB = 2 * hstepB;
    const unsigned ldsw = (unsigned)wid * 1024u;
    const int aoff = lds_byte(wr * 64 + fr, fq * 8), boff = lds_byte(wc * 32 + fr, fq * 8);
#define PG8_SA(b, h) (((b) * 2 + (h)) * HTB)
#define PG8_SB(b, h) ((4 + (b) * 2 + (h)) * HTB)
#define PG8_STAGE(bufoff, gbase, voff) do { _Pragma("unroll") for (int _i = 0; _i < 2; ++_i) \
        __builtin_amdgcn_global_load_lds((const unsigned*)((const char*)(gbase) + (voff)[_i]), (LAS unsigned*)(lds + (bufoff) + ldsw + _i * 8192), 16, 0, 0); } while (0)
#define PG8_LDA(dst, b, h) do { _Pragma("unroll") for (int m = 0; m < 4; ++m) _Pragma("unroll") for (int k = 0; k < 2; ++k) dst[m][k] = *(const LAS bf16x8*)(lds + PG8_SA(b, h) + aoff + m * 2048 + k * 1024); } while (0)
#define PG8_LDB(dst, b, h) do { _Pragma("unroll") for (int n = 0; n < 2; ++n) _Pragma("unroll") for (int k = 0; k < 2; ++k) dst[n][k] = *(const LAS bf16x8*)(lds + PG8_SB(b, h) + boff + n * 2048 + k * 1024); } while (0)
#define PG8_MMA(ai, bj, At, Bt) do { __builtin_amdgcn_s_setprio(1); _Pragma("unroll") for (int m = 0; m < 4; ++m) _Pragma("unroll") for (int n = 0; n < 2; ++n) _Pragma("unroll") for (int k = 0; k < 2; ++k) \
        acc[ai][bj][m][n] = __builtin_amdgcn_mfma_f32_16x16x32_bf16(Bt[n][k], At[m][k], acc[ai][bj][m][n], 0, 0, 0); __builtin_amdgcn_s_setprio(0); } while (0)
#define PG8_WAIT_V(n) asm volatile("s_waitcnt vmcnt(" #n ")" ::: "memory")
#define PG8_WAIT_L(n) asm volatile("s_waitcnt lgkmcnt(" #n ")" ::: "memory")
#define PG8_BAR __builtin_amdgcn_s_barrier()
#define PG8_SCHED __builtin_amdgcn_sched_barrier(0)
    Unit cur, nxt; int ui = 0;
    if (!S.next(0, cur)) return;
    f32x4 acc[2][2][4][2];
#pragma unroll
    for (int a = 0; a < 2; ++a)
#pragma unroll
        for (int b = 0; b < 2; ++b)
#pragma unroll
            for (int m = 0; m < 4; ++m)
#pragma unroll
                for (int n = 0; n < 2; ++n) acc[a][b][m][n] = (f32x4){0.f, 0.f, 0.f, 0.f};
    bf16x8 At[4][2], B0[2][2], B1[2][2];
    const char* cA = (const char*)g.A + (size_t)cur.pm * tstepA + (size_t)((cur.pn >> g.ashift) * g.astep) * 2; const char* cB = (const char*)g.Bt + (size_t)cur.pn * tstepB;
    PG8_STAGE(PG8_SB(0, 0), cB, voffB); PG8_STAGE(PG8_SB(0, 1), cB + hstepB, voffB); PG8_STAGE(PG8_SA(0, 0), cA, voffA); PG8_STAGE(PG8_SA(0, 1), cA + hstepA, voffA);
    if (wr == 1) PG8_BAR;
    PG8_WAIT_V(2); PG8_BAR;
    PG8_STAGE(PG8_SB(1, 0), cB + kstep, voffB); PG8_STAGE(PG8_SA(1, 0), cA + kstep, voffA); PG8_STAGE(PG8_SB(1, 1), cB + hstepB + kstep, voffB);
    PG8_WAIT_V(6); PG8_BAR;
    for (;;) {
        const bool has_next = S.next(ui + 1, nxt);
        const char* nA = has_next ? (const char*)g.A + (size_t)nxt.pm * tstepA + (size_t)((nxt.pn >> g.ashift) * g.astep) * 2 : cA; const char* nB = has_next ? (const char*)g.Bt + (size_t)nxt.pn * tstepB : cB;
        for (int t = 0; t < nt; t += 2) {
            const bool last = (t == nt - 2);
            const char* a1 = cA + (size_t)(t + 1) * kstep;
            const char* a2 = last ? nA : cA + (size_t)(t + 2) * kstep; const char* b2 = last ? nB : cB + (size_t)(t + 2) * kstep;
            const char* a3 = a2 + kstep; const char* b3 = b2 + kstep;
            PG8_LDB(B0, 0, 0); PG8_LDB(B1, 0, 1); PG8_SCHED; PG8_LDA(At, 0, 0); PG8_STAGE(PG8_SA(1, 1), a1 + hstepA, voffA);
            PG8_WAIT_V(8); PG8_WAIT_L(0); PG8_BAR; PG8_MMA(0, 0, At, B0); PG8_MMA(0, 1, At, B1); PG8_BAR; PG8_SCHED;
            PG8_LDA(At, 0, 1); PG8_STAGE(PG8_SB(0, 0), b2, voffB); PG8_STAGE(PG8_SB(0, 1), b2 + hstepB, voffB); PG8_STAGE(PG8_SA(0, 0), a2, voffA);
            PG8_WAIT_V(8); PG8_WAIT_L(0); PG8_BAR; PG8_MMA(1, 0, At, B0); PG8_MMA(1, 1, At, B1); PG8_BAR; PG8_SCHED;
            PG8_LDB(B0, 1, 0); PG8_LDB(B1, 1, 1); PG8_SCHED; PG8_LDA(At, 1, 0); PG8_STAGE(PG8_SA(0, 1), a2 + hstepA, voffA);
            PG8_WAIT_V(8); PG8_WAIT_L(0); PG8_BAR; PG8_MMA(0, 0, At, B0); PG8_MMA(0, 1, At, B1); PG8_BAR; PG8_SCHED;
            PG8_LDA(At, 1, 1); PG8_STAGE(PG8_SB(1, 0), b3, voffB); PG8_STAGE(PG8_SB(1, 1), b3 + hstepB, voffB); PG8_STAGE(PG8_SA(1, 0), a3, voffA);
            PG8_WAIT_V(8); PG8_WAIT_L(0); PG8_BAR; PG8_MMA(1, 0, At, B0); PG8_MMA(1, 1, At, B1); PG8_BAR; PG8_SCHED;
        }
        if (wr == 0) PG8_BAR;
        E(acc, cur, wr, wc, 0, 0);
        if (!has_next) break;
#pragma unroll
        for (int a = 0; a < 2; ++a)
#pragma unroll
            for (int b = 0; b < 2; ++b)
#pragma unroll
                for (int m = 0; m < 4; ++m)
#pragma unroll
                    for (int n = 0; n < 2; ++n) acc[a][b][m][n] = (f32x4){0.f, 0.f, 0.f, 0.f};
        cur = nxt; cA = nA; cB = nB; ++ui;
        if (wr == 1) PG8_BAR;
    }
    PG8_WAIT_V(0);
    PG8_BAR;
#undef PG8_SA
#undef PG8_SB
#undef PG8_STAGE
#undef PG8_LDA
#undef PG8_LDB
#undef PG8_MMA
#undef PG8_WAIT_V
#undef PG8_WAIT_L
#undef PG8_BAR
#undef PG8_SCHED
}


struct EpiZ {
    static constexpr bool PERM = true;
    bf16_t* O; int ldc; const float* bias; int split_cols; size_t split_stride; const float* ss; int act_pn; float* ssv; int ssv_pn0; LAS float* R;
    int post; const bf16_t* pin; bf16_t* pout; const float* pw; const float* pb;
    __device__ __forceinline__ void operator()(const f32x4 (&acc)[2][2][4][2], const Unit& u, int wr, int wc, int fr, int fq) const {
        { const int l_ = lane_id_hw(); fr = l_ & 15; fq = l_ >> 4; }
        if (ss) { if (*(volatile LAS int*)(R + 256) != u.pm) {
            const int wv = 4 * wr + wc; if (wv < 4) { const int r = wv * 64 + fq * 16 + fr; R[r] = rsqrtf(sum16(ss + (size_t)(u.pm * BM + r) * 16) * (1.0f / 1024.0f) + EPS); }
            asm volatile("s_waitcnt lgkmcnt(0)" ::: "memory"); __builtin_amdgcn_s_barrier(); asm volatile("" ::: "memory");
            if (wv == 0 && fq == 0 && fr == 0) *(volatile LAS int*)(R + 256) = u.pm; } }
        const int row0 = u.pm * BM + wr * 64 + fr; int colt = u.pn * BM; bf16_t* base = O;
        if (split_cols) { const int t = colt / split_cols; base += (size_t)t * split_stride; colt -= t * split_cols; }
        const int col0 = colt + wc * 32 + 8 * fq, bcol0 = u.pn * BM + wc * 32 + 8 * fq;
        const bool act = (u.pn < act_pn);
        const bool dss = (ssv != nullptr) && (u.pn >= ssv_pn0);
        f32x4 bv[2][2];
#pragma unroll
        for (int bj = 0; bj < 2; ++bj)
#pragma unroll
            for (int n = 0; n < 2; ++n) bv[bj][n] = bias ? *(const f32x4*)(bias + bcol0 + bj * HALF + 4 * n) : (f32x4){0.f, 0.f, 0.f, 0.f};
#pragma unroll
        for (int ai = 0; ai < 2; ++ai)
#pragma unroll
            for (int m = 0; m < 4; ++m) {
                const int row = row0 + ai * HALF + m * 16;
                float rs = 1.0f; if (ss) rs = R[wr * 64 + fr + ai * HALF + m * 16];
                bf16_t* rowp = base + (size_t)row * ldc + col0; float sq = 0.f;
#pragma unroll
                for (int bj = 0; bj < 2; ++bj) { f32x4 v0 = acc[ai][bj][m][0] * rs + bv[bj][0], v1 = acc[ai][bj][m][1] * rs + bv[bj][1];
                    if (act) { const f32x2v a = gelu_tanh_pk((f32x2v){v0[0], v0[1]}), b = gelu_tanh_pk((f32x2v){v0[2], v0[3]}), c = gelu_tanh_pk((f32x2v){v1[0], v1[1]}), d = gelu_tanh_pk((f32x2v){v1[2], v1[3]});
                        v0 = (f32x4){a.x, a.y, b.x, b.y}; v1 = (f32x4){c.x, c.y, d.x, d.y}; }
                    sq += (v0[0] * v0[0] + v0[1] * v0[1]) + (v0[2] * v0[2] + v0[3] * v0[3]) + (v1[0] * v1[0] + v1[1] * v1[1]) + (v1[2] * v1[2] + v1[3] * v1[3]);
                    u32x4 w; w.x = cvt_pk_bf16(v0[0], v0[1]); w.y = cvt_pk_bf16(v0[2], v0[3]); w.z = cvt_pk_bf16(v1[0], v1[1]); w.w = cvt_pk_bf16(v1[2], v1[3]);
                    *(u32x4*)(rowp + bj * HALF) = w; }
                if (dss) { sq += __shfl_xor(sq, 16); sq += __shfl_xor(sq, 32); if (fq == 0) ssv[(size_t)row * 32 + (u.pn - ssv_pn0) * 4 + wc] = sq; }
                asm volatile("" ::: "memory");
            }
        if (post != 0 && u.pn >= (post == 1 ? 8 : post == 2 ? 4 : 0)) {
            asm volatile("s_waitcnt vmcnt(0)" ::: "memory"); __builtin_amdgcn_s_barrier(); asm volatile("" ::: "memory");
            const int t = (4 * wr + wc) * 64 + fq * 16 + fr, cb0 = (u.pn - (post == 1 ? 8 : post == 2 ? 4 : 0)) * 256;
            const int c = cb0 + (t & 31) * 8, rb = t >> 5, rowb = u.pm * BM + rb * 16;
            if (post == 3) {
                const bf16_t* zb = pin + (size_t)rowb * D + c; bf16_t* yb = pout + (size_t)rowb * D + c;
                if (u.pn == 0) pool_post<2>(zb, yb, rb); else if (u.pn == 1) pool_post<4>(zb, yb, rb); else if (u.pn == 2) pool_post<8>(zb, yb, rb); else pool_post<16>(zb, yb, rb);
            } else if (post == 1) {
                const bf16_t* zb = pin + (size_t)rowb * 3072 + c; bf16_t* yb = pout + (size_t)rowb * D + c;
                f32x4 w[3][2];
#pragma unroll
                for (int k = 0; k < 3; ++k) { w[k][0] = *(const f32x4*)(pw + k * 1024 + c); w[k][1] = *(const f32x4*)(pw + k * 1024 + c + 4); }
                float p2[8], p1[8];
#pragma unroll
                for (int j = 0; j < 8; ++j) { p2[j] = 0.f; p1[j] = 0.f; }
                if (rb > 0) { float a_[8], b_[8]; unpack8(*(const u32x4*)(zb - 2 * 3072 + 1024), a_); unpack8(*(const u32x4*)(zb - 2 * 3072 + 2048), b_);
#pragma unroll
                    for (int j = 0; j < 8; ++j) p2[j] = a_[j] * b_[j];
                    unpack8(*(const u32x4*)(zb - 3072 + 1024), a_); unpack8(*(const u32x4*)(zb - 3072 + 2048), b_);
#pragma unroll
                    for (int j = 0; j < 8; ++j) p1[j] = a_[j] * b_[j]; }
#pragma unroll
                for (int hf = 0; hf < 2; ++hf) {
                    u32x4 cv[8], xv[8], bv[8];
#pragma unroll
                    for (int i = 0; i < 8; ++i) { const bf16_t* zr = zb + (size_t)(hf * 8 + i) * 3072; bv[i] = *(const u32x4*)zr; cv[i] = *(const u32x4*)(zr + 1024); xv[i] = *(const u32x4*)(zr + 2048); }
#pragma unroll
                    for (int i = 0; i < 8; ++i) { float cf[8], xf[8], bf[8], o[8]; unpack8(cv[i], cf); unpack8(xv[i], xf); unpack8(bv[i], bf);
#pragma unroll
                        for (int j = 0; j < 8; ++j) { const float pr = cf[j] * xf[j]; o[j] = bf[j] * (w[0][j >> 2][j & 3] * p2[j] + (w[1][j >> 2][j & 3] * p1[j] + w[2][j >> 2][j & 3] * pr)); p2[j] = p1[j]; p1[j] = pr; }
                        *(u32x4*)(yb + (size_t)(hf * 8 + i) * D) = pack8(o); }
                }
            } else {
                const bf16_t* zb = pin + (size_t)rowb * D + c; bf16_t* yb = pout + (size_t)rowb * D + c;
                f32x4 w[4][2], bb[2];
#pragma unroll
                for (int k = 0; k < 4; ++k) { w[k][0] = *(const f32x4*)(pw + k * 1024 + c); w[k][1] = *(const f32x4*)(pw + k * 1024 + c + 4); }
                bb[0] = *(const f32x4*)(pb + c); bb[1] = *(const f32x4*)(pb + c + 4);
                float q3[8], q2[8], q1[8];
#pragma unroll
                for (int j = 0; j < 8; ++j) { q3[j] = 0.f; q2[j] = 0.f; q1[j] = 0.f; }
                if (rb > 0) { unpack8(*(const u32x4*)(zb - 3 * D), q3); unpack8(*(const u32x4*)(zb - 2 * D), q2); unpack8(*(const u32x4*)(zb - D), q1); }
#pragma unroll
                for (int hf = 0; hf < 2; ++hf) {
                    u32x4 zv[8];
#pragma unroll
                    for (int i = 0; i < 8; ++i) zv[i] = *(const u32x4*)(zb + (size_t)(hf * 8 + i) * D);
#pragma unroll
                    for (int i = 0; i < 8; ++i) { float zf[8], o[8]; unpack8(zv[i], zf);
#pragma unroll
                        for (int j = 0; j < 8; ++j) { o[j] = bb[j >> 2][j & 3] + w[0][j >> 2][j & 3] * q3[j] + (w[1][j >> 2][j & 3] * q2[j] + (w[2][j >> 2][j & 3] * q1[j] + w[3][j >> 2][j & 3] * zf[j])); q3[j] = q2[j]; q2[j] = q1[j]; q1[j] = zf[j]; }
                        *(u32x4*)(yb + (size_t)(hf * 8 + i) * D) = pack8(o); }
                }
            }
        }
    }
};

struct EpiRes {
    static constexpr bool PERM = true;
    bf16_t* xb; float* ssn;
    __device__ __forceinline__ void operator()(const f32x4 (&acc)[2][2][4][2], const Unit& u, int wr, int wc, int fr, int fq) const {
        { const int l_ = lane_id_hw(); fr = l_ & 15; fq = l_ >> 4; }
        const int row0 = u.pm * BM + wr * 64 + fr, col0 = u.pn * BM + wc * 32 + 8 * fq;
        u32x4 xo[2][4][2];
#pragma unroll
        for (int ai = 0; ai < 2; ++ai)
#pragma unroll
            for (int m = 0; m < 4; ++m) { const size_t off = (size_t)(row0 + ai * HALF + m * 16) * D + col0;
#pragma unroll
                for (int bj = 0; bj < 2; ++bj) xo[ai][m][bj] = *(const u32x4*)(xb + off + bj * HALF); }
#pragma unroll
        for (int ai = 0; ai < 2; ++ai) {
#pragma unroll
            for (int m = 0; m < 4; ++m) { const int row = row0 + ai * HALF + m * 16; const size_t off = (size_t)row * D + col0; float sq = 0.f;
#pragma unroll
                for (int bj = 0; bj < 2; ++bj) {
                    float xf[8]; unpack8(xo[ai][m][bj], xf);
                    const f32x4 x0 = (f32x4){xf[0], xf[1], xf[2], xf[3]} + acc[ai][bj][m][0], x1 = (f32x4){xf[4], xf[5], xf[6], xf[7]} + acc[ai][bj][m][1];
                    sq += (x0[0] * x0[0] + x0[1] * x0[1]) + (x0[2] * x0[2] + x0[3] * x0[3]) + (x1[0] * x1[0] + x1[1] * x1[1]) + (x1[2] * x1[2] + x1[3] * x1[3]);
                    u32x4 w; w.x = cvt_pk_bf16(x0[0], x0[1]); w.y = cvt_pk_bf16(x0[2], x0[3]); w.z = cvt_pk_bf16(x1[0], x1[1]); w.w = cvt_pk_bf16(x1[2], x1[3]);
                    *(u32x4*)(xb + off + bj * HALF) = w; }
                sq += __shfl_xor(sq, 16); sq += __shfl_xor(sq, 32); if (fq == 0) ssn[(size_t)row * 16 + u.pn * 4 + wc] = sq; }
            asm volatile("" ::: "memory");
        }
    }
};

struct EpiResFinal {
    static constexpr bool PERM = true;
    const bf16_t* xb; float* ssn; unsigned* cnt; float* out; const float* g; LAS float* R;
    __device__ __forceinline__ void operator()(f32x4 (&acc)[2][2][4][2], const Unit& u, int wr, int wc, int fr, int fq) const {
        { const int l_ = lane_id_hw(); fr = l_ & 15; fq = l_ >> 4; }
        const int row0 = u.pm * BM + wr * 64 + fr, col0 = u.pn * BM + wc * 32 + 8 * fq, wv = 4 * wr + wc;
        u32x4 xo[2][4][2];
#pragma unroll
        for (int ai = 0; ai < 2; ++ai)
#pragma unroll
            for (int m = 0; m < 4; ++m) { const size_t off = (size_t)(row0 + ai * HALF + m * 16) * D + col0;
#pragma unroll
                for (int bj = 0; bj < 2; ++bj) xo[ai][m][bj] = *(const u32x4*)(xb + off + bj * HALF); }
#pragma unroll
        for (int ai = 0; ai < 2; ++ai)
#pragma unroll
            for (int m = 0; m < 4; ++m) { const int row = row0 + ai * HALF + m * 16; float sq = 0.f;
#pragma unroll
                for (int bj = 0; bj < 2; ++bj) {
                    float xf[8]; unpack8(xo[ai][m][bj], xf);
                    const f32x4 x0 = (f32x4){xf[0], xf[1], xf[2], xf[3]} + acc[ai][bj][m][0], x1 = (f32x4){xf[4], xf[5], xf[6], xf[7]} + acc[ai][bj][m][1];
                    sq += (x0[0] * x0[0] + x0[1] * x0[1]) + (x0[2] * x0[2] + x0[3] * x0[3]) + (x1[0] * x1[0] + x1[1] * x1[1]) + (x1[2] * x1[2] + x1[3] * x1[3]);
                    acc[ai][bj][m][0] = x0; acc[ai][bj][m][1] = x1; }
                sq += __shfl_xor(sq, 16); sq += __shfl_xor(sq, 32);
                if (fq == 0) __hip_atomic_store(ssn + (size_t)row * 16 + u.pn * 4 + wc, sq, __ATOMIC_RELAXED, __HIP_MEMORY_SCOPE_AGENT); }
        asm volatile("s_waitcnt vmcnt(0)" ::: "memory"); __builtin_amdgcn_s_barrier(); asm volatile("" ::: "memory");
        if (wv == 0) {
            if (fq == 0 && fr == 0) __hip_atomic_fetch_add(cnt + u.pm, 1u, __ATOMIC_RELAXED, __HIP_MEMORY_SCOPE_AGENT);
            unsigned sp = 0;
            while ((unsigned)__builtin_amdgcn_readfirstlane((int)__hip_atomic_load(cnt + u.pm, __ATOMIC_RELAXED, __HIP_MEMORY_SCOPE_AGENT)) < 4u) { __builtin_amdgcn_s_sleep(1); if (++sp > (1u << 20)) break; }
            __builtin_amdgcn_fence(__ATOMIC_ACQUIRE, "agent");
            asm volatile("s_waitcnt vmcnt(0)" ::: "memory");
        }
        __builtin_amdgcn_s_barrier(); asm volatile("" ::: "memory");
        if (wv < 4) { const int r = wv * 64 + fq * 16 + fr; const float* pp = ssn + (size_t)(u.pm * BM + r) * 16; float q = 0.f;
#pragma unroll
            for (int k = 0; k < 16; ++k) q += __hip_atomic_load(pp + k, __ATOMIC_RELAXED, __HIP_MEMORY_SCOPE_AGENT);
            R[r] = rsqrtf(q * (1.0f / 1024.0f) + EPS); }
        asm volatile("s_waitcnt lgkmcnt(0)" ::: "memory"); __builtin_amdgcn_s_barrier(); asm volatile("" ::: "memory");
        *(volatile LAS int*)(R + 256) = -1;
        f32x4 gv[2][2];
#pragma unroll
        for (int bj = 0; bj < 2; ++bj) { gv[bj][0] = *(const f32x4*)(g + col0 + bj * HALF); gv[bj][1] = *(const f32x4*)(g + col0 + bj * HALF + 4); }
#pragma unroll
        for (int ai = 0; ai < 2; ++ai)
#pragma unroll
            for (int m = 0; m < 4; ++m) { const int rl = wr * 64 + fr + ai * HALF + m * 16; const float rs = R[rl]; float* op = out + (size_t)(u.pm * BM + rl) * D + col0;
#pragma unroll
                for (int bj = 0; bj < 2; ++bj) { *(f32x4*)(op + bj * HALF) = acc[ai][bj][m][0] * rs * gv[bj][0]; *(f32x4*)(op + bj * HALF + 4) = acc[ai][bj][m][1] * rs * gv[bj][1]; } }
    }
};

__device__ __forceinline__ float softplus_neg(float l) { const float e = __expf(-l); return (e < 0.03f) ? e * (1.0f - e * (0.5f - e * (0.33333333f - 0.25f * e))) : __logf(1.0f + e); }
__device__ __forceinline__ float one_minus_exp(float x) { return 1.0f - __expf(x); }
struct EpiGate {
    static constexpr bool PERM = true;
    const bf16_t* xrc; const float* b_a; const float* b_i; const float* lam; unsigned* AB; float* Ls; float* Hs;
    __device__ __forceinline__ void operator()(const f32x4 (&acc)[2][2][4][2], const Unit& u, int wr, int wc, int fr, int fq) const {
        { const int l_ = lane_id_hw(); fr = l_ & 15; fq = l_ >> 4; }
        const int row0 = u.pm * BM + wr * 64 + fr, c0 = (u.pn >> 1) * 256 + (u.pn & 1) * 128 + wc * 32 + 8 * fq;
#pragma unroll
        for (int hf = 0; hf < 2; ++hf) {
            const f32x4 lv = *(const f32x4*)(lam + c0 + 4 * hf), bav = *(const f32x4*)(b_a + c0 + 4 * hf), biv = *(const f32x4*)(b_i + c0 + 4 * hf);
            f32x4 sp;
#pragma unroll
            for (int j = 0; j < 4; ++j) sp[j] = 8.0f * softplus_neg(lv[j]);
#pragma unroll
            for (int ai = 0; ai < 2; ++ai)
#pragma unroll
                for (int m = 0; m < 4; ++m) {
                    const int row = row0 + ai * HALF + m * 16; const size_t off = (size_t)row * D + c0 + 4 * hf;
                    const u32x2 xw = *(const u32x2*)(xrc + off); const float xr[4] = {bf_lo(xw.x), bf_hi(xw.x), bf_lo(xw.y), bf_hi(xw.y)};
                    u32x4 w;
#pragma unroll
                    for (int j2 = 0; j2 < 2; ++j2) { const int j = 2 * j2;
                        const f32x2v rp = (f32x2v){acc[ai][0][m][hf][j], acc[ai][0][m][hf][j + 1]} + (f32x2v){bav[j], bav[j + 1]}, ip = (f32x2v){acc[ai][1][m][hf][j], acc[ai][1][m][hf][j + 1]} + (f32x2v){biv[j], biv[j + 1]};
                        const f32x2v er = rp * (-1.4426950408889634f), ei = ip * (-1.4426950408889634f);
                        f32x2v tr, ti; tr.x = __builtin_amdgcn_exp2f(er.x); tr.y = __builtin_amdgcn_exp2f(er.y); ti.x = __builtin_amdgcn_exp2f(ei.x); ti.y = __builtin_amdgcn_exp2f(ei.y);
                        const f32x2v dr = __builtin_elementwise_min(tr, (f32x2v){1e18f, 1e18f}) + 1.0f, di = __builtin_elementwise_min(ti, (f32x2v){1e18f, 1e18f}) + 1.0f, dd = dr * di;
                        f32x2v t2; t2.x = __builtin_amdgcn_rcpf(dd.x); t2.y = __builtin_amdgcn_rcpf(dd.y);
                        const f32x2v r = t2 * di, ig = t2 * dr;
                        const f32x2v la = r * (f32x2v){-sp[j], -sp[j + 1]}, e2 = la * 2.8853900817779268f;
                        f32x2v a2; a2.x = __builtin_amdgcn_exp2f(e2.x); a2.y = __builtin_amdgcn_exp2f(e2.y);
                        const f32x2v om = __builtin_elementwise_max(1.0f - a2, (f32x2v){0.f, 0.f}); f32x2v mult; mult.x = __builtin_amdgcn_sqrtf(om.x); mult.y = __builtin_amdgcn_sqrtf(om.y);
                        const f32x2v bt = (mult * ig) * (f32x2v){xr[j], xr[j + 1]};
                        w[j] = pack_f16(la.x, bt.x); w[j + 1] = pack_f16(la.y, bt.y); }
                    *(u32x4*)(AB + off) = w;
                    asm volatile("" ::: "memory");
                }
        }
        asm volatile("s_waitcnt vmcnt(0)" ::: "memory"); __builtin_amdgcn_s_barrier(); asm volatile("" ::: "memory");
        { const int t = (4 * wr + wc) * 64 + fq * 16 + fr, chunk = t >> 7, c = (u.pn >> 1) * 256 + (u.pn & 1) * 128 + (t & 127), r0 = u.pm * BM + chunk * 64;
          const unsigned* ab = AB + (size_t)r0 * D + c; float h = 0.f, L = 0.f;
#pragma unroll
          for (int b4 = 0; b4 < 4; ++b4) { unsigned w[16];
#pragma unroll
              for (int i = 0; i < 16; ++i) w[i] = ab[(size_t)(b4 * 16 + i) * D];
#pragma unroll
              for (int i = 0; i < 16; ++i) { const float la = f16_lo(w[i]); h = __expf(la) * h + f16_hi(w[i]); L += la; } }
          const size_t o = (size_t)(r0 >> 6) * 1024 + c; Ls[o] = L; Hs[o] = h; }
    }
};

__device__ __forceinline__ float dpp_ror1(float v) { return __builtin_bit_cast(float, __builtin_amdgcn_mov_dpp(__builtin_bit_cast(int, v), 0x121, 0xf, 0xf, false)); }
__device__ __forceinline__ float dpp_ror2(float v) { return __builtin_bit_cast(float, __builtin_amdgcn_mov_dpp(__builtin_bit_cast(int, v), 0x122, 0xf, 0xf, false)); }
__device__ __forceinline__ float dpp_shr1(float old, float v) { return __builtin_bit_cast(float, __builtin_amdgcn_update_dpp(__builtin_bit_cast(int, old), __builtin_bit_cast(int, v), 0x111, 0xf, 0xf, false)); }
__device__ __forceinline__ float dpp_shr2(float old, float v) { return __builtin_bit_cast(float, __builtin_amdgcn_update_dpp(__builtin_bit_cast(int, old), __builtin_bit_cast(int, v), 0x112, 0xf, 0xf, false)); }
struct EpiFfn {
    static constexpr bool PERM = true;
    bf16_t* A2; const float* ss; const float* cw; const float* cb; float* ZS; LAS float* H;
    __device__ __forceinline__ void operator()(f32x4 (&acc)[2][2][4][2], const Unit& u, int wr, int wc, int fr, int fq) const {
        { const int l_ = lane_id_hw(); fr = l_ & 15; fq = l_ >> 4; }
        const int row0 = u.pm * BM + wr * 64 + fr, tcol = wc * 32 + 8 * fq, c0 = u.pn * 128 + tcol;
        LAS float* R = H + 3 * 2 * 256; LAS float* WL = R + 256 + 64;
        f32x2v wl2; int wl_idx;
        { const int t2 = ((4 * wr + wc) * 64 + fq * 16 + fr) * 2, k = t2 >> 8, tc = t2 & 255; wl_idx = t2;
          const float* src = (k < 3 ? cw + k * 5632 : cb) + (tc >> 7) * FFW + u.pn * 128 + (tc & 127); wl2 = *(const f32x2v*)src; }
        if (*(volatile LAS int*)(R + 256) != u.pm) {
            const int wv = 4 * wr + wc, l_ = lane_id_hw(); if (wv < 4) { const int r = wv * 64 + l_; R[r] = rsqrtf(sum16(ss + (size_t)(u.pm * BM + r) * 16) * (1.0f / 1024.0f) + EPS); }
            asm volatile("s_waitcnt lgkmcnt(0)" ::: "memory"); __builtin_amdgcn_s_barrier(); asm volatile("" ::: "memory");
            if (wv == 0 && l_ == 0) *(volatile LAS int*)(R + 256) = u.pm; }
#pragma unroll
        for (int ai = 0; ai < 2; ++ai)
#pragma unroll
            for (int m = 0; m < 4; ++m) { const float rs = R[wr * 64 + fr + ai * HALF + m * 16];
#pragma unroll
                for (int bj = 0; bj < 2; ++bj) { acc[ai][bj][m][0] *= rs; acc[ai][bj][m][1] *= rs; } }
#pragma unroll
        for (int ai = 0; ai < 2; ++ai) { const int sl = 2 * ai + wr;
            if (fr >= 14) {
#pragma unroll
                for (int bj = 0; bj < 2; ++bj)
#pragma unroll
                    for (int n = 0; n < 2; ++n) {
                        if (sl < 3) *(LAS f32x4*)(H + (sl * 2 + (fr - 14)) * 256 + bj * 128 + tcol + 4 * n) = acc[ai][bj][3][n];
                        else *(f32x4*)(ZS + ((size_t)u.pm * 4 + 2 + (fr - 14)) * 5632 + bj * FFW + c0 + 4 * n) = acc[ai][bj][3][n]; } }
            if (sl == 0 && fr < 2) {
#pragma unroll
                for (int bj = 0; bj < 2; ++bj)
#pragma unroll
                    for (int n = 0; n < 2; ++n) *(f32x4*)(ZS + ((size_t)u.pm * 4 + fr) * 5632 + bj * FFW + c0 + 4 * n) = acc[ai][bj][0][n]; } }
        *(LAS f32x2v*)(WL + wl_idx) = wl2;
        asm volatile("s_waitcnt lgkmcnt(0)" ::: "memory"); __builtin_amdgcn_s_barrier(); asm volatile("" ::: "memory"); __builtin_amdgcn_sched_barrier(0);
        int row0b = row0; asm volatile("" : "+v"(row0b));
#pragma unroll
        for (int hf = 0; hf < 2; ++hf) {
            __builtin_amdgcn_sched_barrier(0);
            const int c = c0 + 4 * hf;
            const LAS float* wl = WL + tcol + 4 * hf;
            const f32x4 wg0 = *(const LAS f32x4*)(wl), wg1 = *(const LAS f32x4*)(wl + 256), wg2 = *(const LAS f32x4*)(wl + 512), bg = *(const LAS f32x4*)(wl + 768);
            const f32x4 wv0 = *(const LAS f32x4*)(wl + 128), wv1 = *(const LAS f32x4*)(wl + 384), wv2 = *(const LAS f32x4*)(wl + 640), bvv = *(const LAS f32x4*)(wl + 896);
#pragma unroll
            for (int ai = 0; ai < 2; ++ai) { const int sl = 2 * ai + wr;
                f32x4 qg = (f32x4){0.f, 0.f, 0.f, 0.f}, qv = (f32x4){0.f, 0.f, 0.f, 0.f};
                if (sl > 0) { const LAS float* hp = H + ((sl - 1) * 2 + (fr & 1)) * 256 + tcol + 4 * hf; qg = *(const LAS f32x4*)hp; qv = *(const LAS f32x4*)(hp + 128); }
#pragma unroll
                for (int m = 0; m < 4; ++m) {
                    const f32x4 cg = acc[ai][0][m][hf], cv = acc[ai][1][m][hf]; float o[4];
#pragma unroll
                    for (int j2 = 0; j2 < 2; ++j2) {
                        const int j = 2 * j2;
                        const f32x2v g1 = {dpp_shr1(dpp_ror1(qg[j]), cg[j]), dpp_shr1(dpp_ror1(qg[j + 1]), cg[j + 1])}, g2 = {dpp_shr2(dpp_ror2(qg[j]), cg[j]), dpp_shr2(dpp_ror2(qg[j + 1]), cg[j + 1])};
                        const f32x2v v1 = {dpp_shr1(dpp_ror1(qv[j]), cv[j]), dpp_shr1(dpp_ror1(qv[j + 1]), cv[j + 1])}, v2 = {dpp_shr2(dpp_ror2(qv[j]), cv[j]), dpp_shr2(dpp_ror2(qv[j + 1]), cv[j + 1])};
                        const f32x2v c_g = {cg[j], cg[j + 1]}, c_v = {cv[j], cv[j + 1]};
                        const f32x2v gc = (f32x2v){wg0[j], wg0[j + 1]} * g2 + ((f32x2v){wg1[j], wg1[j + 1]} * g1 + ((f32x2v){wg2[j], wg2[j + 1]} * c_g + (f32x2v){bg[j], bg[j + 1]}));
                        const f32x2v vc = (f32x2v){wv0[j], wv0[j + 1]} * v2 + ((f32x2v){wv1[j], wv1[j + 1]} * v1 + ((f32x2v){wv2[j], wv2[j + 1]} * c_v + (f32x2v){bvv[j], bvv[j + 1]}));
                        const f32x2v e = gc * (-1.4426950408889634f); f32x2v t; t.x = __builtin_amdgcn_exp2f(e.x); t.y = __builtin_amdgcn_exp2f(e.y);
                        const f32x2v d = t + 1.0f; f32x2v r; r.x = __builtin_amdgcn_rcpf(d.x); r.y = __builtin_amdgcn_rcpf(d.y);
                        const f32x2v oo = (gc * r) * vc; o[j] = oo.x; o[j + 1] = oo.y; }
                    u32x2 w; w.x = cvt_pk_bf16(o[0], o[1]); w.y = cvt_pk_bf16(o[2], o[3]);
                    *(u32x2*)(A2 + (size_t)(row0b + ai * HALF + m * 16) * FFW + c) = w;
                    qg = cg; qv = cv; }
                __builtin_amdgcn_sched_barrier(0); }
        }
    }
};
}

struct TrJob { const float* W; const float* gain; bf16_t* dst; int ldw, sc0, nblk, K, drb, inter, r; bool found; };
__device__ __forceinline__ TrJob tr_select(const Params& p, bf16_t* WB, int it) {
    int r = it; bool found = false;
    int wi = 0, ldw = 0, sc0 = 0, nblk = 1, K = 64, drb = 0, inter = 0, gi = -1, goff = 0; size_t woff = 0, doff = 0;
#define JOB(wi_, woff_, ldw_, sc0_, ncols_, K_, doff_, drb_, inter_, gi_, goff_) if (!found) { const int ni = ((K_) / 64) * ((ncols_) / 32); if (r < ni) { wi = (wi_); woff = (size_t)(woff_); ldw = (ldw_); sc0 = (sc0_); nblk = (ncols_) / 32; K = (K_); doff = (size_t)(doff_); drb = (drb_); inter = (inter_); gi = (gi_); goff = (goff_); found = true; } else r -= ni; }
    JOB(2, 0, 4096, 0, 4096, 1024, O_A_IN, 0, 0, 1, 0)
    JOB(7, 0, 1024, 0, 1024, 2048, O_A_OUT, 0, 0, -1, 0)
    JOB(9, 0, 1024, 0, 1024, 1024, O_B_IN, 0, 0, 8, 0)
    for (int g = 0; g < 4; ++g) JOB(10, g * 65536, 256, 0, 256, 256, O_B_GRP + g * 65536, 0, 0, -1, 0)
    JOB(13, 0, 1024, 0, 1024, 1024, O_B_OUT, 0, 0, 12, 0)
    JOB(15, 0, 2048, 0, 2048, 1024, O_C_IN, 0, 0, 14, 0)
    for (int h = 0; h < 4; ++h) { JOB(19, h * 65536, 256, 0, 256, 256, O_C_GATE, h * 512, 1, -1, 0) JOB(21, h * 65536, 256, 0, 256, 256, O_C_GATE, h * 512 + 128, 1, -1, 0) }
    JOB(24, 0, 1024, 0, 1024, 1024, O_C_OUT, 0, 0, -1, 0)
    JOB(26, 0, 3072, 0, 3072, 1024, O_D_IN, 0, 0, 25, 0)
    JOB(28, 0, 1024, 0, 1024, 1024, O_D_OUT, 0, 0, -1, 0)
    for (int l = 0; l < 4; ++l) {
        JOB(30, (size_t)l * 1024 * 5632, 5632, 0, 2816, 1024, O_F + l * (F_UP_SZ + F_DN_SZ), 0, 1, 29, l * 1024)
        JOB(30, (size_t)l * 1024 * 5632, 5632, 2816, 2816, 1024, O_F + l * (F_UP_SZ + F_DN_SZ), 128, 1, 29, l * 1024)
        JOB(33, (size_t)l * 2816 * 1024, 1024, 0, 1024, 2816, O_F + l * (F_UP_SZ + F_DN_SZ) + F_UP_SZ, 0, 0, -1, 0)
    }
#undef JOB
    TrJob j; j.W = p.in[wi] + woff; j.gain = (gi >= 0) ? p.in[gi] + goff : nullptr; j.dst = WB + doff; j.ldw = ldw; j.sc0 = sc0; j.nblk = nblk; j.K = K; j.drb = drb; j.inter = inter; j.r = r; j.found = found;
    return j;
}
__device__ __forceinline__ void tr_load(const TrJob& j, float (&wv)[32], int lane) {
    const int kb = j.r / j.nblk, nb = j.r % j.nblk, k0 = 64 * kb, c0 = 32 * nb;
    const float* src = j.W + (size_t)(k0 + (lane >> 5)) * j.ldw + j.sc0 + c0 + (lane & 31);
#pragma unroll
    for (int i = 0; i < 32; ++i) wv[i] = src[(size_t)(2 * i) * j.ldw];
}
__device__ __forceinline__ void tr_store(const TrJob& j, const float (&wv)[32], LAS float* scr, int lane) {
    const int kb = j.r / j.nblk, nb = j.r % j.nblk, k0 = 64 * kb, c0 = 32 * nb;
#pragma unroll
    for (int i = 0; i < 32; ++i) { const int kk = 2 * i + (lane >> 5); scr[kk * 33 + (lane & 31)] = wv[i]; }
    asm volatile("s_waitcnt lgkmcnt(0)" ::: "memory");
    const int c = lane & 7;
    f32x4 g0 = (f32x4){1.f, 1.f, 1.f, 1.f}, g1 = g0;
    if (j.gain) { g0 = *(const f32x4*)(j.gain + k0 + 8 * c); g1 = *(const f32x4*)(j.gain + k0 + 8 * c + 4); }
#pragma unroll
    for (int q = 0; q < 4; ++q) { const int n = (lane >> 3) + 8 * q; const LAS float* s = scr + (8 * c) * 33 + n;
        const int crel = c0 + n; const int drow = j.drb + (j.inter ? ((crel >> 7) * 256 + (crel & 127)) : crel);
        u32x4 o; o.x = cvt_pk_bf16(s[0 * 33] * g0[0], s[1 * 33] * g0[1]); o.y = cvt_pk_bf16(s[2 * 33] * g0[2], s[3 * 33] * g0[3]); o.z = cvt_pk_bf16(s[4 * 33] * g1[0], s[5 * 33] * g1[1]); o.w = cvt_pk_bf16(s[6 * 33] * g1[2], s[7 * 33] * g1[3]);
        *(u32x4*)(j.dst + (size_t)drow * j.K + k0 + 8 * c) = o; }
    asm volatile("s_waitcnt lgkmcnt(0)" ::: "memory");
}

__device__ __forceinline__ void prologue_phase(const Params& p, LAS unsigned char* lds, const int tid, const int bx) {
    const int lane = tid & 63, wave = tid >> 6;
    const int gw = bx * 8 + wave, NGW = gridDim.x * 8;
    LAS float* scr = (LAS float*)(lds + wave * 16384);
    bf16_t* WB = (bf16_t*)(p.ws + WS_W);
    constexpr int TOTAL = (int)(O_END / 2048);
    {
        int it = gw; float cur[32], nxt[32]; TrJob job, jobn;
        if (it < TOTAL) { job = tr_select(p, WB, it); tr_load(job, cur, lane); }
        while (it < TOTAL) {
            const int itn = it + NGW; const bool hn = itn < TOTAL;
            if (hn) { jobn = tr_select(p, WB, itn); tr_load(jobn, nxt, lane); }
            tr_store(job, cur, scr, lane);
            if (hn) { job = jobn;
#pragma unroll
                for (int i = 0; i < 32; ++i) cur[i] = nxt[i]; }
            it = itn;
        }
    }
    const float* x = p.in[0]; bf16_t* xb = (bf16_t*)(p.ws + WS_XB); float* SS = (float*)(p.ws + WS_SS);
    for (int rowq = gw; rowq < M / 4; rowq += NGW) {
        f32x4 v[4][4];
#pragma unroll
        for (int q = 0; q < 4; ++q) { const f32x4* xr = (const f32x4*)(x + (size_t)(rowq * 4 + q) * D) + lane;
#pragma unroll
            for (int j = 0; j < 4; ++j) v[q][j] = xr[64 * j]; }
#pragma unroll
        for (int q = 0; q < 4; ++q) { const int row = rowq * 4 + q; u32x2* o = (u32x2*)(xb + (size_t)row * D) + lane; float s = 0.f;
#pragma unroll
            for (int j = 0; j < 4; ++j) { const f32x4 vv = v[q][j]; s += (vv[0] * vv[0] + vv[1] * vv[1]) + (vv[2] * vv[2] + vv[3] * vv[3]); u32x2 w; w.x = cvt_pk_bf16(vv[0], vv[1]); w.y = cvt_pk_bf16(vv[2], vv[3]); o[64 * j] = w; }
            s = wave_sum(s); if (lane < 16) SS[(size_t)row * 16 + lane] = (lane == 0) ? s : 0.f; }
    }
}

__device__ __forceinline__ void gmlp_gate_phase(const Params& p, LAS unsigned char* lds, bf16_t* U, const bf16_t* V, const float* ssv, const int tid, const int bx) {
    const int lane = tid & 63, wave = tid >> 6, fr = lane & 15, fq = lane >> 4;
    const float* w_s = p.in[5]; const float* b_s = p.in[6]; const float* gv = p.in[4];
    LAS bf16_t* Wm = (LAS bf16_t*)lds;
    LAS bf16_t* Vs = (LAS bf16_t*)(lds + 128 * 272);
    LAS float* Rv = (LAS float*)(lds + 128 * 272 + 128 * 516);
    for (int item = bx; item < 2048; item += gridDim.x) {
        const int chunk = item >> 3, g = (item >> 1) & 3, half = item & 1;
        const int tok0 = chunk * 128, colb = g * 512 + half * 256;
        {
            const float* pp = ssv + (size_t)(tok0 + (tid >> 2)) * 32 + (tid & 3) * 8; const f32x4 a = *(const f32x4*)pp, b = *(const f32x4*)(pp + 4);
            float q = ((a[0] + a[1]) + (a[2] + a[3])) + ((b[0] + b[1]) + (b[2] + b[3])); q += __shfl_xor(q, 1); q += __shfl_xor(q, 2);
            if ((tid & 3) == 0) Rv[tid >> 2] = rsqrtf(q * (1.0f / 2048.0f) + EPS); }
        __syncthreads();
#pragma unroll
        for (int i = 0; i < 4; ++i) { const int pc = tid + 512 * i, t = pc >> 4, s0 = (pc & 15) * 8;
            const f32x4 w0 = *(const f32x4*)(w_s + ((size_t)g * 128 + t) * 128 + s0), w1 = *(const f32x4*)(w_s + ((size_t)g * 128 + t) * 128 + s0 + 4);
            float f[8];
#pragma unroll
            for (int j = 0; j < 4; ++j) { f[j] = (s0 + j <= t) ? w0[j] * Rv[s0 + j] : 0.f; f[4 + j] = (s0 + 4 + j <= t) ? w1[j] * Rv[s0 + 4 + j] : 0.f; }
            *(LAS u32x4*)(Wm + t * 136 + s0) = pack8(f); }
#pragma unroll
        for (int i = 0; i < 8; ++i) { const int pc = tid + 512 * i, s = pc >> 5, d0 = (pc & 31) * 8;
            const u32x4 v = *(const u32x4*)(V + (size_t)(tok0 + s) * 2048 + colb + d0);
            LAS unsigned* dst = (LAS unsigned*)(Vs + s * 258 + d0); dst[0] = v.x; dst[1] = v.y; dst[2] = v.z; dst[3] = v.w; }
        __syncthreads();
        f32x4 acc[8][2]; u32x2 upre[8][2];
#pragma unroll
        for (int mb = 0; mb < 8; ++mb) { acc[mb][0] = (f32x4){0.f, 0.f, 0.f, 0.f}; acc[mb][1] = (f32x4){0.f, 0.f, 0.f, 0.f};
#pragma unroll
            for (int nb = 0; nb < 2; ++nb) upre[mb][nb] = *(const u32x2*)(U + (size_t)(tok0 + mb * 16 + fr) * 2048 + colb + wave * 32 + nb * 16 + 4 * fq); }
#pragma unroll
        for (int kk = 0; kk < 4; ++kk) {
            bf16x8 vf[2];
#pragma unroll
            for (int nb = 0; nb < 2; ++nb) { const int d = wave * 32 + nb * 16 + fr;
#pragma unroll
                for (int j = 0; j < 8; ++j) vf[nb][j] = (short)Vs[(kk * 32 + fq * 8 + j) * 258 + d]; }
#pragma unroll
            for (int mb = 0; mb < 8; ++mb) { if (32 * kk <= 16 * mb + 15) {
                const bf16x8 wf = *(const LAS bf16x8*)(Wm + (mb * 16 + fr) * 136 + kk * 32 + fq * 8);
                acc[mb][0] = __builtin_amdgcn_mfma_f32_16x16x32_bf16(vf[0], wf, acc[mb][0], 0, 0, 0);
                acc[mb][1] = __builtin_amdgcn_mfma_f32_16x16x32_bf16(vf[1], wf, acc[mb][1], 0, 0, 0); } }
        }
#pragma unroll
        for (int mb = 0; mb < 8; ++mb) { const int t = mb * 16 + fr; const float bs = b_s[g * 128 + t];
#pragma unroll
            for (int nb = 0; nb < 2; ++nb) { const int col = colb + wave * 32 + nb * 16 + 4 * fq;
                const f32x4 gg = *(const f32x4*)(gv + col); bf16_t* up = U + (size_t)(tok0 + t) * 2048 + col;
                const u32x2 uw = upre[mb][nb];
                const float o0 = bf_lo(uw.x) * (acc[mb][nb][0] * gg[0] + bs), o1 = bf_hi(uw.x) * (acc[mb][nb][1] * gg[1] + bs), o2 = bf_lo(uw.y) * (acc[mb][nb][2] * gg[2] + bs), o3 = bf_hi(uw.y) * (acc[mb][nb][3] * gg[3] + bs);
                u32x2 ow; ow.x = cvt_pk_bf16(o0, o1); ow.y = cvt_pk_bf16(o2, o3); *(u32x2*)up = ow; } }
        __syncthreads();
    }
}

__device__ __forceinline__ void ffn_gate_phase(const bf16_t* Zc, bf16_t* A2, const float* cw, const float* cb, int gtid, int NT) {
    constexpr int NCG = FFW / 8; const int total = 8192 * NCG;
    for (int idx = gtid; idx < total; idx += NT) {
        const int lr = idx / NCG, cgp = idx - lr * NCG, c = cgp * 8, zc = (c >> 7) * 256 + (c & 127), tseq = lr & (SEQ - 1);
        float g[8], v[8];
        { const f32x4 a0 = *(const f32x4*)(cb + c), a1 = *(const f32x4*)(cb + c + 4), b0 = *(const f32x4*)(cb + FFW + c), b1 = *(const f32x4*)(cb + FFW + c + 4);
#pragma unroll
          for (int j = 0; j < 4; ++j) { g[j] = a0[j]; g[4 + j] = a1[j]; v[j] = b0[j]; v[4 + j] = b1[j]; } }
#pragma unroll
        for (int k = 0; k < 3; ++k) { const int dt = 2 - k; if (tseq >= dt) {
            const bf16_t* zp = Zc + (size_t)(lr - dt) * 5632 + zc; float zg[8], zv[8]; unpack8(*(const u32x4*)zp, zg); unpack8(*(const u32x4*)(zp + 128), zv);
            const f32x4 wg0 = *(const f32x4*)(cw + k * 5632 + c), wg1 = *(const f32x4*)(cw + k * 5632 + c + 4), wv0 = *(const f32x4*)(cw + k * 5632 + FFW + c), wv1 = *(const f32x4*)(cw + k * 5632 + FFW + c + 4);
#pragma unroll
            for (int j = 0; j < 4; ++j) { g[j] += wg0[j] * zg[j]; g[4 + j] += wg1[j] * zg[4 + j]; v[j] += wv0[j] * zv[j]; v[4 + j] += wv1[j] * zv[4 + j]; } } }
        float o[8];
#pragma unroll
        for (int j = 0; j < 8; ++j) o[j] = siluf_(g[j]) * v[j];
        *(u32x4*)(A2 + (size_t)lr * FFW + c) = pack8(o);
    }
}

__device__ __forceinline__ void scan1_phase(const unsigned* AB, float* Ls, float* Hs, int gtid, int NT) {
    for (int idx = gtid; idx < 8 * 64 * 512; idx += NT) {
        const int cp = idx & 511, j = (idx >> 9) & 63, b = idx >> 15, c = 2 * cp; const size_t row0 = (size_t)b * SEQ + j * 64;
        float h0 = 0.f, h1 = 0.f, L0 = 0.f, L1 = 0.f;
#pragma unroll 8
        for (int i = 0; i < 64; ++i) { const u32x2 w = *(const u32x2*)(AB + (row0 + i) * D + c);
            const float la0 = f16_lo(w.x), la1 = f16_lo(w.y); h0 = __expf(la0) * h0 + f16_hi(w.x); h1 = __expf(la1) * h1 + f16_hi(w.y); L0 += la0; L1 += la1; }
        const size_t o = ((size_t)b * 64 + j) * 1024 + c; Ls[o] = L0; Ls[o + 1] = L1; Hs[o] = h0; Hs[o + 1] = h1;
    }
}
__device__ __forceinline__ void scan2_phase(const unsigned* AB, const float* Ls, const float* Hs, const bf16_t* G, bf16_t* Y, int gtid, int NT) {
    for (int idx = gtid; idx < 8 * 64 * 256; idx += NT) {
        const int cq = idx & 255, j = (idx >> 8) & 63, b = idx >> 14, c = 4 * cq; const size_t row0 = (size_t)b * SEQ + j * 64;
        f32x4 h = (f32x4){0.f, 0.f, 0.f, 0.f};
#pragma unroll 8
        for (int jj = 0; jj < j; ++jj) { const size_t o = ((size_t)b * 64 + jj) * 1024 + c; const f32x4 l = *(const f32x4*)(Ls + o), hh = *(const f32x4*)(Hs + o);
#pragma unroll
            for (int k = 0; k < 4; ++k) h[k] = __expf(l[k]) * h[k] + hh[k]; }
#pragma unroll
        for (int b4 = 0; b4 < 4; ++b4) {
            u32x4 w[16]; u32x2 gq[16];
#pragma unroll
            for (int i = 0; i < 16; ++i) { const size_t off = (row0 + b4 * 16 + i) * D + c; w[i] = *(const u32x4*)(AB + off); gq[i] = *(const u32x2*)(G + off); }
#pragma unroll
            for (int i = 0; i < 16; ++i) {
#pragma unroll
                for (int k = 0; k < 4; ++k) h[k] = __expf(f16_lo(w[i][k])) * h[k] + f16_hi(w[i][k]);
                u32x2 yo; yo.x = cvt_pk_bf16(h[0] * bf_lo(gq[i].x), h[1] * bf_hi(gq[i].x)); yo.y = cvt_pk_bf16(h[2] * bf_lo(gq[i].y), h[3] * bf_hi(gq[i].y));
                *(u32x2*)(Y + (row0 + b4 * 16 + i) * D + c) = yo; }
        }
    }
}

__device__ __forceinline__ void final_norm_phase(float* out, const bf16_t* xb, const float* ss, const float* g, const int tid, const int bx) {
    const int lane = tid & 63, gw = bx * 8 + (tid >> 6), NGW = gridDim.x * 8;
    const f32x4* gr = (const f32x4*)g + 2 * lane;
    const f32x4 g00 = gr[0], g01 = gr[1], g10 = gr[128], g11 = gr[129];
    for (int rowq = gw; rowq < M / 4; rowq += NGW) {
        float rs[4]; u32x4 xv[4][2];
#pragma unroll
        for (int q = 0; q < 4; ++q) { const int row = rowq * 4 + q; rs[q] = sum16(ss + (size_t)row * 16); const u32x4* xr = (const u32x4*)(xb + (size_t)row * D) + lane; xv[q][0] = xr[0]; xv[q][1] = xr[64]; }
#pragma unroll
        for (int q = 0; q < 4; ++q) { const int row = rowq * 4 + q; const float r = rsqrtf(rs[q] * (1.0f / 1024.0f) + EPS); f32x4* o = (f32x4*)(out + (size_t)row * D) + 2 * lane;
            float xf[8]; unpack8(xv[q][0], xf); o[0] = (f32x4){xf[0], xf[1], xf[2], xf[3]} * r * g00; o[1] = (f32x4){xf[4], xf[5], xf[6], xf[7]} * r * g01;
            unpack8(xv[q][1], xf); o[128] = (f32x4){xf[0], xf[1], xf[2], xf[3]} * r * g10; o[129] = (f32x4){xf[4], xf[5], xf[6], xf[7]} * r * g11; }
    }
}

#define XB_TMO      128
#define XB_XCNT(j)  (256  + 64 * (j))
#define XB_XSUB(j)  (1280 + 64 * (j))
#define XB_XGEN(j)  (2304 + 64 * (j))
#define XB_TOP      3328
#define XB_TOPGEN   3392
#define XCD_BAR_WORDS 3456
#define XB_SPIN_CAP (1u << 20)
__device__ __forceinline__ unsigned xb_ld(unsigned* p)              { return __hip_atomic_load(p, __ATOMIC_RELAXED, __HIP_MEMORY_SCOPE_AGENT); }
__device__ __forceinline__ unsigned xb_add(unsigned* p, unsigned v) { return __hip_atomic_fetch_add(p, v, __ATOMIC_RELAXED, __HIP_MEMORY_SCOPE_AGENT); }
__device__ __forceinline__ unsigned xb_xcc_id() { return (unsigned)__builtin_amdgcn_s_getreg((3 << 11) | 20) & 0xFu; }
#define XB_SPIN(cond, bar) do { unsigned _sp = 0; while (cond) { __builtin_amdgcn_s_sleep(1); \
    if ((++_sp & 255u) == 0u) { if (xb_ld(&(bar)[XB_TMO])) break; if (_sp > XB_SPIN_CAP) { atomicAdd(&(bar)[XB_TMO], 1u); break; } } } } while (0)
__device__ __forceinline__ void xcd_barrier_complete(unsigned* bar, unsigned x, unsigned& nloc, unsigned& nx) {
    const unsigned G = gridDim.x * gridDim.y * gridDim.z;
    unsigned sum, cnt, mine, sp = 0u;
    for (;;) {
        sum = 0u; cnt = 0u; mine = 0u;
#pragma unroll
        for (unsigned j = 0; j < 16; ++j) { const unsigned c = xb_ld(&bar[XB_XCNT(j)]); sum += c; cnt += (c > 0u) ? 1u : 0u; mine = (j == x) ? c : mine; }
        if (sum == G) break;
        __builtin_amdgcn_s_sleep(1);
        if ((++sp & 255u) == 0u) { if (xb_ld(&bar[XB_TMO])) break; if (sp > XB_SPIN_CAP) { atomicAdd(&bar[XB_TMO], 1u); break; } }
    }
    nloc = mine > 0u ? mine : 1u; nx = cnt > 0u ? cnt : 1u;
}
__device__ __forceinline__ void xcd_barrier(unsigned* bar, volatile LAS unsigned* st, const bool leader) {
    asm volatile("s_waitcnt vmcnt(0)" ::: "memory");
    __syncthreads();
    if (leader) {
        const unsigned x = xb_xcc_id();
        __builtin_amdgcn_s_waitcnt(0);
        unsigned nloc = st[0], nx = st[1];
        if (nloc == 0u) { xcd_barrier_complete(bar, x, nloc, nx); st[0] = nloc; st[1] = nx; }
        const unsigned old = xb_add(&bar[XB_XSUB(x)], 1u);
        const unsigned gen = old / nloc;
        if (old + 1u == (gen + 1u) * nloc) {
            __builtin_amdgcn_fence(__ATOMIC_RELEASE, "agent");
            asm volatile("s_waitcnt vmcnt(0)" ::: "memory");
            const unsigned og = xb_add(&bar[XB_TOP], 1u);
            const unsigned tg = og / nx;
            if (og + 1u == (tg + 1u) * nx) xb_add(&bar[XB_TOPGEN], 1u);
            else XB_SPIN(xb_ld(&bar[XB_TOPGEN]) == tg, bar);
            __builtin_amdgcn_fence(__ATOMIC_ACQUIRE, "agent");
            xb_add(&bar[XB_XGEN(x)], 1u);
            asm volatile("s_waitcnt vmcnt(0)" ::: "memory");
        } else {
            XB_SPIN(xb_ld(&bar[XB_XGEN(x)]) == gen, bar);
            __builtin_amdgcn_fence(__ATOMIC_ACQUIRE, "agent");
            asm volatile("s_waitcnt vmcnt(0)" ::: "memory");
        }
    }
    __syncthreads();
}

#ifndef KINDS
#define KINDS 31
#endif
enum { K_PROLOGUE = 0, K_GEMM_FFN, K_GEMM_Z, K_GEMM_RES, K_GEMM_GATE, K_GMLP, K_FFNGATE, K_POOL, K_CONV4, K_SCAN1, K_SCAN2, K_SHORTCONV, K_FINAL };
constexpr int NPHASES = 1 + 3 + 2 + 3 + 2 + 4 + 2 + 2 + 2;

__global__ void __launch_bounds__(NTHREADS) mega_fwd(Params p) {
    extern __shared__ __attribute__((aligned(16))) unsigned char lds_raw[];
    LAS unsigned char* lds = (LAS unsigned char*)lds_raw;
    cg::grid_group grid = cg::this_grid();
    const int NT = gridDim.x * NTHREADS, G = gridDim.x;
    const int wid_s = __builtin_amdgcn_readfirstlane((int)threadIdx.x >> 6);
    volatile LAS unsigned* bst = (volatile LAS unsigned*)(lds + 131072 + 512);
    if (threadIdx.x == 0) { bst[0] = 0u; bst[1] = 0u; (void)xb_add(&((unsigned*)(p.ws + WS_BAR))[XB_XCNT(xb_xcc_id())], 1u); }
    __syncthreads();
#define SSK(k) (SS + (size_t)(k) * M * 16)

#ifndef PROBE_PH
#define PROBE_PH 1000
#endif
#ifndef PROBE_REPS
#define PROBE_REPS 0
#endif
    for (int phx = 0; phx < NPHASES + PROBE_REPS; ++phx) {
        const int ph = (phx <= PROBE_PH) ? phx : ((phx - PROBE_PH <= PROBE_REPS) ? PROBE_PH : phx - PROBE_REPS);
        int tid = wid_s * 64 + lane_id_hw(); asm volatile("" : "+v"(tid));
        int bx = blockIdx.x; asm volatile("" : "+s"(bx));
        unsigned char* ws = p.ws; asm volatile("" : "+s"(ws));
        float* X = p.out; asm volatile("" : "+s"(X));
        const int gtid = bx * NTHREADS + tid;
        float* SS = (float*)(ws + WS_SS);
        bf16_t* WB = (bf16_t*)(ws + WS_W);
        bf16_t* xb = (bf16_t*)(ws + WS_XB);
        unsigned char* AR = ws + WS_ARENA;
        int seg, q = ph;
        if (q == 0) seg = 0;
        else if ((q -= 1) < 3) seg = 1;
        else if ((q -= 3) < 2) seg = 8;
        else if ((q -= 2) < 3) seg = 2;
        else if ((q -= 3) < 2) seg = 9;
        else if ((q -= 2) < 4) seg = 3;
        else if ((q -= 4) < 2) seg = 10;
        else if ((q -= 2) < 2) seg = 4;
        else if ((q -= 2) < 2) seg = 11;
        else seg = 5;
        int kind;
        if (seg == 0) kind = K_PROLOGUE;
        else if (seg == 1) kind = (q == 0) ? K_GEMM_Z : (q == 1) ? K_GMLP : K_GEMM_RES;
        else if (seg == 2) kind = (q == 0) ? K_GEMM_Z : (q == 1) ? K_GEMM_Z : K_GEMM_RES;
        else if (seg == 3) kind = (q == 0) ? K_GEMM_Z : (q == 1) ? K_GEMM_GATE : (q == 2) ? K_SCAN2 : K_GEMM_RES;
        else if (seg == 4) kind = (q == 0) ? K_GEMM_Z : K_GEMM_RES;
        else if (seg == 5) kind = K_FINAL;
        else kind = (q == 0) ? K_GEMM_FFN : K_GEMM_RES;
        const int fl = seg - 8;

        if (kind == K_PROLOGUE) prologue_phase(p, lds, tid, bx);
        else if (kind == K_GEMM_FFN) {
            pg8::Gemm g{xb, WB + O_F + fl * (F_UP_SZ + F_DN_SZ), D, D, 128, 22, 0, 0};
            pg8::EpiFfn ef{(bf16_t*)AR, SSK(2 * fl + 1), p.in[31] + (size_t)fl * 3 * 5632, p.in[32] + (size_t)fl * 5632, (float*)(AR + 176 * MiB), (LAS float*)(lds + 131072 + 1024)};
            pg8::StaticOrder S; S.init(128, 22, G, bx, FFN_WGM);
            pg8::gemm_phase(lds, g, S, ef, tid);
        }
#if KINDS & 1
        else if (kind == K_GEMM_Z) {
            size_t a_off = WS_XB, w_off = 0, o_off = WS_ARENA, split_stride = 0; int lda = D, K = D, nM = 128, nN = 4, astep = 0, ldc = D, bias_i = -1, split_cols = 0, ss_k = -1, ss_row = 0, act_pn = 0, ssv_on = 0, post = 0;
            if (seg == 1) { w_off = O_A_IN; nN = 16; ldc = 2048; bias_i = 3; split_cols = 2048; split_stride = (size_t)64 * MiB; ss_k = 0; act_pn = 16; ssv_on = 1; }
            else if (seg == 2 && q == 0) { w_off = O_B_IN; ss_k = 2; post = 3; }
            else if (seg == 2) { a_off = WS_ARENA + 64 * MiB; w_off = O_B_GRP; K = 256; astep = 256; o_off = WS_ARENA + 128 * MiB; bias_i = 11; }
            else if (seg == 3) { w_off = O_C_IN; nN = 8; bias_i = 16; split_cols = 1024; split_stride = (size_t)32 * MiB; ss_k = 4; act_pn = 4; post = 2; }
            else { w_off = O_D_IN; nN = 12; ldc = 3072; ss_k = 6; post = 1; }
            pg8::Gemm g{(const bf16_t*)(ws + a_off), WB + w_off, lda, K, nM, nN, 0, astep};
            pg8::EpiZ ez{(bf16_t*)(ws + o_off), ldc, bias_i >= 0 ? p.in[bias_i] : nullptr, split_cols, split_stride, ss_k >= 0 ? SSK(ss_k) + (size_t)ss_row * 16 : nullptr, act_pn, ssv_on ? (float*)(ws + WS_SSV) : nullptr, 8, (LAS float*)(lds + 131072 + 1024 + 6144),
                         post, post == 2 ? (const bf16_t*)(AR + 64 * MiB) : (const bf16_t*)AR, post == 1 ? (bf16_t*)(AR + 192 * MiB) : post == 2 ? (bf16_t*)(AR + 128 * MiB) : (bf16_t*)(AR + 64 * MiB), post == 1 ? p.in[27] : p.in[17], p.in[18]};
            pg8::StaticOrder S; S.init(nM, nN, G, bx);
            if (seg == 2 && q == 1) {
                pg8::Unit uu;
                for (int i = 0; S.next(i, uu); ++i) { if ((uu.pm & 15) == 0) continue;
                    const int win = 2 << uu.pn, r = tid >> 5;
                    if (r < win - 1) pool_item((const bf16_t*)AR, (bf16_t*)(AR + 64 * MiB), uu.pm * 256 + r, uu.pn * 256 + (tid & 31) * 8, win, (uu.pm * 256 + r) & (SEQ - 1)); }
                asm volatile("s_waitcnt vmcnt(0)" ::: "memory"); __syncthreads();
            }
            pg8::gemm_phase(lds, g, S, ez, tid);
        }
#endif
#if KINDS & 2
        else if (kind == K_GEMM_RES) {
            size_t a_off = WS_ARENA, w_off = O_A_OUT; int K = D, ssn = 1;
            if (seg == 1) { K = 2048; }
            else if (seg == 2) { a_off = WS_ARENA + 128 * MiB; w_off = O_B_OUT; ssn = 3; }
            else if (seg == 3) { a_off = WS_ARENA + 64 * MiB; w_off = O_C_OUT; ssn = 5; }
            else if (seg == 4) { a_off = WS_ARENA + 192 * MiB; w_off = O_D_OUT; ssn = 7; }
            else { a_off = WS_ARENA; w_off = O_F + fl * (F_UP_SZ + F_DN_SZ) + F_UP_SZ; K = FFW; ssn = 2 * fl + 2; }
            pg8::Gemm g{(const bf16_t*)(ws + a_off), WB + w_off, K, K, 128, 4, 0, 0};
            pg8::EpiRes er{xb, SSK(ssn)};
            pg8::StaticOrder S; S.init(128, 4, G, bx);
            if (seg == 4) {
                pg8::Unit uu;
                for (int i = 0; S.next(i, uu); ++i) { if ((uu.pm & 15) == 0) continue;
                    if (tid < 256) shortconv_item((const bf16_t*)AR, (bf16_t*)(AR + 192 * MiB), p.in[27], uu.pm * 256 + (tid >> 7), (tid & 127) * 8, 2); }
                asm volatile("s_waitcnt vmcnt(0)" ::: "memory"); __syncthreads();
            }
            if (seg >= 8) {
                const float* ZS = (const float*)(AR + 176 * MiB); bf16_t* A2 = (bf16_t*)AR; const float* cw = p.in[31] + (size_t)fl * 3 * 5632; const float* cb = p.in[32] + (size_t)fl * 5632;
                pg8::Unit uu;
                for (int i = 0; S.next(i, uu); ++i) { if ((uu.pm & 15) == 0) continue;
                    for (int idx = tid; idx < 2 * 704; idx += NTHREADS) { const int r = idx / 704, c = (idx - r * 704) * 4;
                        f32x4 gsum = *(const f32x4*)(cb + c), vsum = *(const f32x4*)(cb + FFW + c);
#pragma unroll
                        for (int k = 0; k < 3; ++k) { const int j = r - 2 + k; const float* zr = (j < 0) ? ZS + ((size_t)(uu.pm - 1) * 4 + 4 + j) * 5632 : ZS + ((size_t)uu.pm * 4 + j) * 5632;
                            gsum += *(const f32x4*)(cw + k * 5632 + c) * *(const f32x4*)(zr + c); vsum += *(const f32x4*)(cw + k * 5632 + FFW + c) * *(const f32x4*)(zr + FFW + c); }
                        u32x2 w; w.x = cvt_pk_bf16(siluf_(gsum[0]) * vsum[0], siluf_(gsum[1]) * vsum[1]); w.y = cvt_pk_bf16(siluf_(gsum[2]) * vsum[2], siluf_(gsum[3]) * vsum[3]);
                        *(u32x2*)(A2 + (size_t)(uu.pm * 256 + r) * FFW + c) = w; } }
                asm volatile("s_waitcnt vmcnt(0)" ::: "memory"); __syncthreads();
            }
            if (seg == 11) {
                pg8::EpiResFinal ef{xb, SSK(8), (unsigned*)(ws + WS_BAR) + 3584, X, p.in[34], (LAS float*)(lds + 131072 + 1024 + 6144)};
                pg8::gemm_phase(lds, g, S, ef, tid);
            } else
            pg8::gemm_phase(lds, g, S, er, tid);
        }
#endif
#if KINDS & 4
        else if (kind == K_GEMM_GATE) {
            pg8::Gemm g{(bf16_t*)(AR + 128 * MiB), WB + O_C_GATE, D, 256, 128, 8, 1, 256};
            pg8::EpiGate eg{(const bf16_t*)(AR + 128 * MiB), p.in[20], p.in[22], p.in[23], (unsigned*)(AR + 192 * MiB), (float*)(ws + WS_SCAN), (float*)(ws + WS_SCAN) + 8 * 64 * 1024};
            pg8::StaticOrder S; S.init(g.nM, g.nN, G, bx);
            {
                pg8::Unit uu;
                for (int i = 0; S.next(i, uu); ++i) { if ((uu.pm & 15) == 0) continue;
                    if (tid < 96) conv4_item((const bf16_t*)(AR + 64 * MiB), (bf16_t*)(AR + 128 * MiB), p.in[17], p.in[18], uu.pm * 256 + (tid >> 5), (uu.pn >> 1) * 256 + (tid & 31) * 8, 3); }
                asm volatile("s_waitcnt vmcnt(0)" ::: "memory"); __syncthreads();
            }
            pg8::gemm_phase(lds, g, S, eg, tid);
        }
#endif
#if KINDS & 8
        else if (kind == K_GMLP) gmlp_gate_phase(p, lds, (bf16_t*)AR, (const bf16_t*)(AR + 128 * MiB), (const float*)(ws + WS_SSV), tid, bx);
#endif
#if KINDS & 16
        else if (kind == K_SCAN2) scan2_phase((const unsigned*)(AR + 192 * MiB), (const float*)(ws + WS_SCAN), (const float*)(ws + WS_SCAN) + 8 * 64 * 1024, (const bf16_t*)AR, (bf16_t*)(AR + 64 * MiB), gtid, NT);
#endif
        if (wid_s == 0 && lane_id_hw() == 0) *(volatile LAS int*)(lds + 131072 + 1024 + 6144 + 1024) = -1;
        if (p.out == nullptr) { asm volatile("s_waitcnt vmcnt(0)" ::: "memory"); grid.sync(); }
        else if (phx + 1 < NPHASES + PROBE_REPS) xcd_barrier((unsigned*)(p.ws + WS_BAR), bst, wid_s == 0 && lane_id_hw() == 0);
    }
}

extern "C" void kernel_launch(void* const* d_in, const int* in_sizes, int n_in, void* d_out, int out_size, void* d_ws, size_t ws_size, hipStream_t stream) {
    static int grid = 0;
    if (grid == 0) {
        if (n_in != 35 || out_size != M * D || ws_size < WS_NEED) { fprintf(stderr, "kernel_launch: unexpected shapes: n_in %d out %d ws %zu\n", n_in, out_size, ws_size); grid = -1; return; }
        int dev = 0, cus = 0, per_cu = 0;
        (void)hipGetDevice(&dev); (void)hipDeviceGetAttribute(&cus, hipDeviceAttributeMultiprocessorCount, dev);
        if (hipFuncSetAttribute((const void*)mega_fwd, hipFuncAttributeMaxDynamicSharedMemorySize, LDS_BYTES) != hipSuccess) { fprintf(stderr, "kernel_launch: hipFuncSetAttribute failed\n"); grid = -1; return; }
        if (hipOccupancyMaxActiveBlocksPerMultiprocessor(&per_cu, (const void*)mega_fwd, NTHREADS, LDS_BYTES) != hipSuccess || per_cu < 1) { fprintf(stderr, "kernel_launch: occupancy query says %d\n", per_cu); per_cu = 1; }
        (void)hipGetLastError();
        grid = cus;
        if (cus != 256) { fprintf(stderr, "kernel_launch: built for a 256-CU device (fused conv stages rely on the 256-workgroup unit order), found %d\n", cus); grid = -1; return; }
        fprintf(stderr, "kernel_launch: grid %d (per_cu %d)\n", grid, per_cu);
    }
    if (grid < 0) return;
    if (hipMemsetAsync((char*)d_ws + WS_BAR, 0, 16384, stream) != hipSuccess) { fprintf(stderr, "kernel_launch: memset failed\n"); return; }
    Params p{};
    for (int i = 0; i < 35; ++i) p.in[i] = (const float*)d_in[i];
    p.out = (float*)d_out; p.ws = (unsigned char*)d_ws;
    void* args[] = {&p};
    hipError_t e = hipLaunchCooperativeKernel((const void*)mega_fwd, dim3(grid), dim3(NTHREADS), args, LDS_BYTES, stream);
    if (e != hipSuccess) fprintf(stderr, "kernel_launch: cooperative launch failed: %s\n", hipGetErrorString(e));
}
```

```cpp
#include <hip/hip_runtime.h>
#include <hip/hip_cooperative_groups.h>
#include <cstdio>
#include <cstdint>
namespace cg = cooperative_groups;

#define LAS __attribute__((address_space(3)))
typedef unsigned short bf16_t;
typedef short bf16x8 __attribute__((ext_vector_type(8)));
typedef float f32x4 __attribute__((ext_vector_type(4)));
typedef unsigned u32x4 __attribute__((ext_vector_type(4)));
typedef unsigned u32x2 __attribute__((ext_vector_type(2)));
typedef float f32x2v __attribute__((ext_vector_type(2)));

constexpr int M = 32768, D = 1024, SEQ = 4096;
constexpr int FFW = 2816;
constexpr float EPS = 1e-6f;
constexpr int NTHREADS = 512;
#ifndef FFN_WGM
#define FFN_WGM 4
#endif
constexpr int LDS_BYTES = 147456;
constexpr size_t MiB = 1u << 20;

constexpr size_t WS_SS = 0;
constexpr size_t WS_SSV = 18 * MiB;
constexpr size_t WS_SCAN = 22 * MiB;
constexpr size_t WS_W = 26 * MiB;
constexpr size_t WS_XB = 124 * MiB;
constexpr size_t WS_ARENA = 188 * MiB;
constexpr size_t WS_BAR = 123 * MiB + 768 * 1024;
constexpr size_t WS_NEED = 512 * MiB;

constexpr size_t O_A_IN = 0;
constexpr size_t O_A_OUT = O_A_IN + (size_t)4096 * 1024;
constexpr size_t O_B_IN = O_A_OUT + (size_t)1024 * 2048;
constexpr size_t O_B_GRP = O_B_IN + (size_t)1024 * 1024;
constexpr size_t O_B_OUT = O_B_GRP + (size_t)4 * 256 * 256;
constexpr size_t O_C_IN = O_B_OUT + (size_t)1024 * 1024;
constexpr size_t O_C_GATE = O_C_IN + (size_t)2048 * 1024;
constexpr size_t O_C_OUT = O_C_GATE + (size_t)2048 * 256;
constexpr size_t O_D_IN = O_C_OUT + (size_t)1024 * 1024;
constexpr size_t O_D_OUT = O_D_IN + (size_t)3072 * 1024;
constexpr size_t O_F = O_D_OUT + (size_t)1024 * 1024;
constexpr size_t F_UP_SZ = (size_t)5632 * 1024, F_DN_SZ = (size_t)1024 * 2816;
constexpr size_t O_END = O_F + 4 * (F_UP_SZ + F_DN_SZ);
static_assert(WS_W + O_END * 2 <= WS_BAR && WS_BAR + 16384 <= WS_XB, "weights fit");

struct Params { const float* in[35]; float* out; unsigned char* ws; };

__device__ __forceinline__ unsigned cvt_pk_bf16(float lo, float hi) { unsigned r; asm("v_cvt_pk_bf16_f32 %0, %1, %2" : "=v"(r) : "v"(lo), "v"(hi)); return r; }
__device__ __forceinline__ float bf_lo(unsigned w) { return __uint_as_float(w << 16); }
__device__ __forceinline__ float bf_hi(unsigned w) { return __uint_as_float(w & 0xffff0000u); }
__device__ __forceinline__ void unpack8(const u32x4 w, float (&f)[8]) { f[0] = bf_lo(w.x); f[1] = bf_hi(w.x); f[2] = bf_lo(w.y); f[3] = bf_hi(w.y); f[4] = bf_lo(w.z); f[5] = bf_hi(w.z); f[6] = bf_lo(w.w); f[7] = bf_hi(w.w); }
__device__ __forceinline__ u32x4 pack8(const float (&f)[8]) { u32x4 w; w.x = cvt_pk_bf16(f[0], f[1]); w.y = cvt_pk_bf16(f[2], f[3]); w.z = cvt_pk_bf16(f[4], f[5]); w.w = cvt_pk_bf16(f[6], f[7]); return w; }
__device__ __forceinline__ float sigmoidf_(float x) { return 1.0f / (1.0f + __expf(-x)); }
__device__ __forceinline__ float gelu_tanh(float x) { const float u = 1.5957691216057308f * (x + 0.044715f * x * x * x); return x * sigmoidf_(u); }
__device__ __forceinline__ float siluf_(float x) { return x * sigmoidf_(x); }
__device__ __forceinline__ f32x2v gelu_tanh_pk(f32x2v x) {
    const f32x2v x2 = x * x, u = x * (x2 * 0.044715f + 1.0f), e = u * (-2.3022082f);
    f32x2v t; t.x = __builtin_amdgcn_exp2f(e.x); t.y = __builtin_amdgcn_exp2f(e.y);
    const f32x2v d = t + 1.0f; f32x2v r; r.x = __builtin_amdgcn_rcpf(d.x); r.y = __builtin_amdgcn_rcpf(d.y);
    return x * r; }
__device__ __forceinline__ unsigned pack_f16(float lo, float hi) { const _Float16 a = (_Float16)lo, b = (_Float16)hi; return (unsigned)__builtin_bit_cast(unsigned short, a) | ((unsigned)__builtin_bit_cast(unsigned short, b) << 16); }
__device__ __forceinline__ float f16_lo(unsigned w) { return (float)__builtin_bit_cast(_Float16, (unsigned short)(w & 0xffffu)); }
__device__ __forceinline__ float f16_hi(unsigned w) { return (float)__builtin_bit_cast(_Float16, (unsigned short)(w >> 16)); }
__device__ __forceinline__ int lane_id_hw() { int l; asm volatile("v_mbcnt_lo_u32_b32 %0, -1, 0\n\tv_mbcnt_hi_u32_b32 %0, -1, %0" : "=v"(l)); return l; }
__device__ __forceinline__ float wave_sum(float v) {
#pragma unroll
    for (int o = 1; o < 64; o <<= 1) v += __shfl_xor(v, o);
    return v;
}

__device__ __forceinline__ float sum16(const float* p) { const f32x4 a = *(const f32x4*)p, b = *(const f32x4*)(p + 4), c = *(const f32x4*)(p + 8), d = *(const f32x4*)(p + 12);
    return ((a[0] + a[1]) + (a[2] + a[3])) + ((b[0] + b[1]) + (b[2] + b[3])) + (((c[0] + c[1]) + (c[2] + c[3])) + ((d[0] + d[1]) + (d[2] + d[3]))); }

__device__ __forceinline__ void conv4_item(const bf16_t* XR, bf16_t* XRc, const float* cw, const float* cb, int row, int c, int tlim) {
    float a[8];
    { const f32x4 b0 = *(const f32x4*)(cb + c), b1 = *(const f32x4*)(cb + c + 4);
#pragma unroll
      for (int j = 0; j < 4; ++j) { a[j] = b0[j]; a[4 + j] = b1[j]; } }
#pragma unroll
    for (int k = 0; k < 4; ++k) { const int dt = 3 - k; if (tlim >= dt) { float z[8]; unpack8(*(const u32x4*)(XR + (size_t)(row - dt) * D + c), z);
        const f32x4 w0 = *(const f32x4*)(cw + k * 1024 + c), w1 = *(const f32x4*)(cw + k * 1024 + c + 4);
#pragma unroll
        for (int j = 0; j < 4; ++j) { a[j] += w0[j] * z[j]; a[4 + j] += w1[j] * z[4 + j]; } } }
    *(u32x4*)(XRc + (size_t)row * D + c) = pack8(a);
}
__device__ __forceinline__ void shortconv_item(const bf16_t* Z, bf16_t* Y, const float* cw, int row, int c, int tlim) {
    float a[8];
#pragma unroll
    for (int j = 0; j < 8; ++j) a[j] = 0.f;
#pragma unroll
    for (int k = 0; k < 3; ++k) { const int dt = 2 - k; if (tlim >= dt) { const bf16_t* zp = Z + (size_t)(row - dt) * 3072 + c; float cgv[8], xv[8]; unpack8(*(const u32x4*)(zp + 1024), cgv); unpack8(*(const u32x4*)(zp + 2048), xv);
        const f32x4 w0 = *(const f32x4*)(cw + k * 1024 + c), w1 = *(const f32x4*)(cw + k * 1024 + c + 4);
#pragma unroll
        for (int j = 0; j < 4; ++j) { a[j] += w0[j] * (cgv[j] * xv[j]); a[4 + j] += w1[j] * (cgv[4 + j] * xv[4 + j]); } } }
    float bg[8]; unpack8(*(const u32x4*)(Z + (size_t)row * 3072 + c), bg);
#pragma unroll
    for (int j = 0; j < 8; ++j) a[j] *= bg[j];
    *(u32x4*)(Y + (size_t)row * D + c) = pack8(a);
}

__device__ __forceinline__ void pool_item(const bf16_t* Z, bf16_t* P, int row, int c, int win, int tseq) {
    const int cnt = (tseq + 1 < win) ? tseq + 1 : win;
    float s[8], z0[8];
    unpack8(*(const u32x4*)(Z + (size_t)row * D + c), z0);
#pragma unroll
    for (int j = 0; j < 8; ++j) s[j] = z0[j];
    for (int i = 1; i < cnt; ++i) { float z[8]; unpack8(*(const u32x4*)(Z + (size_t)(row - i) * D + c), z);
#pragma unroll
        for (int j = 0; j < 8; ++j) s[j] += z[j]; }
    const float inv = 1.0f / (float)cnt; float o[8];
#pragma unroll
    for (int j = 0; j < 8; ++j) o[j] = s[j] * inv - z0[j];
    *(u32x4*)(P + (size_t)row * D + c) = pack8(o);
}
template <int WIN>
__device__ __forceinline__ void pool_post(const bf16_t* zb, bf16_t* yb, int rb) {
    u32x4 zv[16 + WIN - 1];
    if (rb > 0) {
#pragma unroll
        for (int i = 0; i < WIN - 1; ++i) zv[i] = *(const u32x4*)(zb + (ptrdiff_t)(i - (WIN - 1)) * D); }
#pragma unroll
    for (int i = 0; i < 16; ++i) zv[WIN - 1 + i] = *(const u32x4*)(zb + (size_t)i * D);
    float S[8];
#pragma unroll
    for (int j = 0; j < 8; ++j) S[j] = 0.f;
    if (rb > 0) {
#pragma unroll
        for (int i = 0; i < WIN - 1; ++i) { float z[8]; unpack8(zv[i], z);
#pragma unroll
            for (int j = 0; j < 8; ++j) S[j] += z[j]; } }
#pragma unroll
    for (int r = 0; r < 16; ++r) { float z[8], o[8]; unpack8(zv[WIN - 1 + r], z);
        const float inv = (rb > 0 || r + 1 >= WIN) ? (1.0f / (float)WIN) : (1.0f / (float)(r + 1));
#pragma unroll
        for (int j = 0; j < 8; ++j) { S[j] += z[j]; o[j] = S[j] * inv - z[j]; }
        *(u32x4*)(yb + (size_t)r * D) = pack8(o);
        if (rb > 0 || r + 1 >= WIN) { float zo[8]; unpack8(zv[r], zo);
#pragma unroll
            for (int j = 0; j < 8; ++j) S[j] -= zo[j]; } }
}

namespace pg8 {
constexpr int BM = 256, BK = 64, HALF = 128, HTB = HALF * BK * 2, STAGE_BYTES = 8 * HTB, NXCD = 8, WGM = 8;
__device__ __forceinline__ int lds_byte(int r, int c) { const int st = (r >> 4) * 2 + (c >> 5), rr = r & 15, cc = c & 31, ob = rr * 64 + cc * 2; return st * 1024 + (ob ^ (((ob >> 9) & 1) << 5)); }
__device__ __forceinline__ void stage_rc(int b, int& R, int& C) { const int st = b / 1024, sb = b % 1024, swz = sb ^ (((sb >> 9) & 1) << 5); R = (st >> 1) * 16 + swz / 64; C = (st & 1) * 32 + (swz % 64) / 2; }
__device__ __forceinline__ int perm32(int rho) { const int n = rho >> 4, i = rho & 15; return 8 * (i >> 2) + 4 * n + (i & 3); }

struct Unit { int pm, pn; };
struct Gemm { const bf16_t* A; const bf16_t* Bt; int lda, K, nM, nN, ashift, astep; };

struct StaticOrder {
    int nM, nN, nwg, G, c, wgm;
    __device__ void init(int nM_, int nN_, int G_, int c_, int wgm_ = WGM) { nM = nM_; nN = nN_; nwg = nM * nN; G = G_; c = c_; wgm = wgm_; }
    __device__ bool next(int i, Unit& u) const {
        const long L = (long)i * G + c; if (L >= nwg) return false;
        int wgid = (int)L; { const int q = nwg / NXCD, r = nwg % NXCD, xcd = wgid % NXCD, off = wgid / NXCD; wgid = (xcd < r ? xcd * (q + 1) : r * (q + 1) + (xcd - r) * q) + off; }
        const int nig = wgm * nN, gid = wgid / nig, fm = gid * wgm, gsz = (nM - fm) < wgm ? (nM - fm) : wgm;
        u.pm = fm + ((wgid % nig) % gsz); u.pn = (wgid % nig) / gsz; return true;
    }
};

template <class Epi>
__device__ __forceinline__ void gemm_phase(LAS unsigned char* lds, const Gemm g, const StaticOrder& S, const Epi& E, const int tid) {
    const int wid = __builtin_amdgcn_readfirstlane(tid >> 6), lane = tid & 63, wr = wid >> 2, wc = wid & 3, fr = lane & 15, fq = lane >> 4;
    int K = g.K, lda = g.lda; asm volatile("" : "+s"(K), "+s"(lda));
    const int nt = K / BK;
    unsigned voffA[2], voffB[2];
#pragma unroll
    for (int i = 0; i < 2; ++i) { int R, C; stage_rc(tid * 16 + i * 8192, R, C); const int Rb = Epi::PERM ? ((R & ~31) + perm32(R & 31)) : R;
        const int Ra = Epi::ROWPERM ? ((R & ~63) | ((R & 15) << 2) | ((R >> 4) & 3)) : R;
        voffA[i] = (unsigned)(Ra * lda + C) * 2u; voffB[i] = (unsigned)(Rb * K + C) * 2u; }
    const size_t kstep = (size_t)(BK * 2);
    const size_t hstepA = (size_t)HALF * lda * 2, hstepB = (size_t)HALF * K * 2;
    const size_t tstepA = 2 * hstepA, tstepB = 2 * hstepB;
    const unsigned ldsw = (unsigned)wid * 1024u;
    const int aoff = lds_byte(wr * 64 + fr, fq * 8), boff = lds_byte(wc * 32 + fr, fq * 8);
#define PG8_SA(b, h) (((b) * 2 + (h)) * HTB)
#define PG8_SB(b, h) ((4 + (b) * 2 + (h)) * HTB)
#define PG8_STAGE(bufoff, gbase, voff) do { _Pragma("unroll") for (int _i = 0; _i < 2; ++_i) \
        __builtin_amdgcn_global_load_lds((const unsigned*)((const char*)(gbase) + (voff)[_i]), (LAS unsigned*)(lds + (bufoff) + ldsw + _i * 8192), 16, 0, 0); } while (0)
#define PG8_LDA(dst, b, h) do { _Pragma("unroll") for (int m = 0; m < 4; ++m) _Pragma("unroll") for (int k = 0; k < 2; ++k) dst[m][k] = *(const LAS bf16x8*)(lds + PG8_SA(b, h) + aoff + m * 2048 + k * 1024); } while (0)
#define PG8_LDB(dst, b, h) do { _Pragma("unroll") for (int n = 0; n < 2; ++n) _Pragma("unroll") for (int k = 0; k < 2; ++k) dst[n][k] = *(const LAS bf16x8*)(lds + PG8_SB(b, h) + boff + n * 2048 + k * 1024); } while (0)
#define PG8_MMA(ai, bj, At, Bt) do { __builtin_amdgcn_s_setprio(1); _Pragma("unroll") for (int m = 0; m < 4; ++m) _Pragma("unroll") for (int n = 0; n < 2; ++n) _Pragma("unroll") for (int k = 0; k < 2; ++k) \
        acc[ai][bj][m][n] = __builtin_amdgcn_mfma_f32_16x16x32_bf16(Bt[n][k], At[m][k], acc[ai][bj][m][n], 0, 0, 0); __builtin_amdgcn_s_setprio(0); } while (0)
#define PG8_WAIT_V(n) asm volatile("s_waitcnt vmcnt(" #n ")" ::: "memory")
#define PG8_WAIT_L(n) asm volatile("s_waitcnt lgkmcnt(" #n ")" ::: "memory")
#define PG8_BAR __builtin_amdgcn_s_barrier()
#define PG8_SCHED __builtin_amdgcn_sched_barrier(0)
    Unit cur, nxt; int ui = 0;
    if (!S.next(0, cur)) return;
    f32x4 acc[2][2][4][2];
#pragma unroll
    for (int a = 0; a < 2; ++a)
#pragma unroll
        for (int b = 0; b < 2; ++b)
#pragma unroll
            for (int m = 0; m < 4; ++m)
#pragma unroll
                for (int n = 0; n < 2; ++n) acc[a][b][m][n] = (f32x4){0.f, 0.f, 0.f, 0.f};
    bf16x8 At[4][2], B0[2][2], B1[2][2];
    const char* cA = (const char*)g.A + (size_t)cur.pm * tstepA + (size_t)((cur.pn >> g.ashift) * g.astep) * 2; const char* cB = (const char*)g.Bt + (size_t)cur.pn * tstepB;
    PG8_STAGE(PG8_SB(0, 0), cB, voffB); PG8_STAGE(PG8_SB(0, 1), cB + hstepB, voffB); PG8_STAGE(PG8_SA(0, 0), cA, voffA); PG8_STAGE(PG8_SA(0, 1), cA + hstepA, voffA);
    if (wr == 1) PG8_BAR;
    PG8_WAIT_V(2); PG8_BAR;
    PG8_STAGE(PG8_SB(1, 0), cB + kstep, voffB); PG8_STAGE(PG8_SA(1, 0), cA + kstep, voffA); PG8_STAGE(PG8_SB(1, 1), cB + hstepB + kstep, voffB);
    PG8_WAIT_V(6); PG8_BAR;
    for (;;) {
        const bool has_next = S.next(ui + 1, nxt);
        const char* nA = has_next ? (const char*)g.A + (size_t)nxt.pm * tstepA + (size_t)((nxt.pn >> g.ashift) * g.astep) * 2 : cA; const char* nB = has_next ? (const char*)g.Bt + (size_t)nxt.pn * tstepB : cB;
        for (int t = 0; t < nt; t += 2) {
            const bool last = (t == nt - 2);
            const char* a1 = cA + (size_t)(t + 1) * kstep;
            const char* a2 = last ? nA : cA + (size_t)(t + 2) * kstep; const char* b2 = last ? nB : cB + (size_t)(t + 2) * kstep;
            const char* a3 = a2 + kstep; const char* b3 = b2 + kstep;
            PG8_LDB(B0, 0, 0); PG8_LDB(B1, 0, 1); PG8_SCHED; PG8_LDA(At, 0, 0); PG8_STAGE(PG8_SA(1, 1), a1 + hstepA, voffA);
            PG8_WAIT_V(8); PG8_WAIT_L(0); PG8_BAR; PG8_MMA(0, 0, At, B0); PG8_MMA(0, 1, At, B1); PG8_BAR; PG8_SCHED;
            PG8_LDA(At, 0, 1); PG8_STAGE(PG8_SB(0, 0), b2, voffB); PG8_STAGE(PG8_SB(0, 1), b2 + hstepB, voffB); PG8_STAGE(PG8_SA(0, 0), a2, voffA);
            PG8_WAIT_V(8); PG8_WAIT_L(0); PG8_BAR; PG8_MMA(1, 0, At, B0); PG8_MMA(1, 1, At, B1); PG8_BAR; PG8_SCHED;
            PG8_LDB(B0, 1, 0); PG8_LDB(B1, 1, 1); PG8_SCHED; PG8_LDA(At, 1, 0); PG8_STAGE(PG8_SA(0, 1), a2 + hstepA, voffA);
            PG8_WAIT_V(8); PG8_WAIT_L(0); PG8_BAR; PG8_MMA(0, 0, At, B0); PG8_MMA(0, 1, At, B1); PG8_BAR; PG8_SCHED;
            PG8_LDA(At, 1, 1); PG8_STAGE(PG8_SB(1, 0), b3, voffB); PG8_STAGE(PG8_SB(1, 1), b3 + hstepB, voffB); PG8_STAGE(PG8_SA(1, 0), a3, voffA);
            PG8_WAIT_V(8); PG8_WAIT_L(0); PG8_BAR; PG8_MMA(1, 0, At, B0); PG8_MMA(1, 1, At, B1); PG8_BAR; PG8_SCHED;
        }
        if (wr == 0) PG8_BAR;
        E(acc, cur, wr, wc, 0, 0);
        if (!has_next) break;
#pragma unroll
        for (int a = 0; a < 2; ++a)
#pragma unroll
            for (int b = 0; b < 2; ++b)
#pragma unroll
                for (int m = 0; m < 4; ++m)
#pragma unroll
                    for (int n = 0; n < 2; ++n) acc[a][b][m][n] = (f32x4){0.f, 0.f, 0.f, 0.f};
        cur = nxt; cA = nA; cB = nB; ++ui;
        if (wr == 1) PG8_BAR;
    }
    PG8_WAIT_V(0);
    PG8_BAR;
#undef PG8_SA
#undef PG8_SB
#undef PG8_STAGE
#undef PG8_LDA
#undef PG8_LDB
#undef PG8_MMA
#undef PG8_WAIT_V
#undef PG8_WAIT_L
#undef PG8_BAR
#undef PG8_SCHED
}


struct EpiZ {
    static constexpr bool PERM = true, ROWPERM = false;
    bf16_t* O; int ldc; const float* bias; int split_cols; size_t split_stride; const float* ss; int act_pn; float* ssv; int ssv_pn0; LAS float* R;
    int post; const bf16_t* pin; bf16_t* pout; const float* pw; const float* pb;
    __device__ __forceinline__ void operator()(const f32x4 (&acc)[2][2][4][2], const Unit& u, int wr, int wc, int fr, int fq) const {
        { const int l_ = lane_id_hw(); fr = l_ & 15; fq = l_ >> 4; }
        if (ss) { if (*(volatile LAS int*)(R + 256) != u.pm) {
            const int wv = 4 * wr + wc; if (wv < 4) { const int r = wv * 64 + fq * 16 + fr; R[r] = rsqrtf(sum16(ss + (size_t)(u.pm * BM + r) * 16) * (1.0f / 1024.0f) + EPS); }
            asm volatile("s_waitcnt lgkmcnt(0)" ::: "memory"); __builtin_amdgcn_s_barrier(); asm volatile("" ::: "memory");
            if (wv == 0 && fq == 0 && fr == 0) *(volatile LAS int*)(R + 256) = u.pm; } }
        const int row0 = u.pm * BM + wr * 64 + fr; int colt = u.pn * BM; bf16_t* base = O;
        if (split_cols) { const int t = colt / split_cols; base += (size_t)t * split_stride; colt -= t * split_cols; }
        const int col0 = colt + wc * 32 + 8 * fq, bcol0 = u.pn * BM + wc * 32 + 8 * fq;
        const bool act = (u.pn < act_pn);
        const bool dss = (ssv != nullptr) && (u.pn >= ssv_pn0);
        f32x4 bv[2][2];
#pragma unroll
        for (int bj = 0; bj < 2; ++bj)
#pragma unroll
            for (int n = 0; n < 2; ++n) bv[bj][n] = bias ? *(const f32x4*)(bias + bcol0 + bj * HALF + 4 * n) : (f32x4){0.f, 0.f, 0.f, 0.f};
#pragma unroll
        for (int ai = 0; ai < 2; ++ai)
#pragma unroll
            for (int m = 0; m < 4; ++m) {
                const int row = row0 + ai * HALF + m * 16;
                float rs = 1.0f; if (ss) rs = R[wr * 64 + fr + ai * HALF + m * 16];
                bf16_t* rowp = base + (size_t)row * ldc + col0; float sq = 0.f;
#pragma unroll
                for (int bj = 0; bj < 2; ++bj) { f32x4 v0 = acc[ai][bj][m][0] * rs + bv[bj][0], v1 = acc[ai][bj][m][1] * rs + bv[bj][1];
                    if (act) { const f32x2v a = gelu_tanh_pk((f32x2v){v0[0], v0[1]}), b = gelu_tanh_pk((f32x2v){v0[2], v0[3]}), c = gelu_tanh_pk((f32x2v){v1[0], v1[1]}), d = gelu_tanh_pk((f32x2v){v1[2], v1[3]});
                        v0 = (f32x4){a.x, a.y, b.x, b.y}; v1 = (f32x4){c.x, c.y, d.x, d.y}; }
                    sq += (v0[0] * v0[0] + v0[1] * v0[1]) + (v0[2] * v0[2] + v0[3] * v0[3]) + (v1[0] * v1[0] + v1[1] * v1[1]) + (v1[2] * v1[2] + v1[3] * v1[3]);
                    u32x4 w; w.x = cvt_pk_bf16(v0[0], v0[1]); w.y = cvt_pk_bf16(v0[2], v0[3]); w.z = cvt_pk_bf16(v1[0], v1[1]); w.w = cvt_pk_bf16(v1[2], v1[3]);
                    *(u32x4*)(rowp + bj * HALF) = w; }
                if (dss) { sq += __shfl_xor(sq, 16); sq += __shfl_xor(sq, 32); if (fq == 0) ssv[(size_t)row * 32 + (u.pn - ssv_pn0) * 4 + wc] = sq; }
                asm volatile("" ::: "memory");
            }
        if (post != 0 && u.pn >= (post == 1 ? 8 : post == 2 ? 4 : 0)) {
            asm volatile("s_waitcnt vmcnt(0)" ::: "memory"); __builtin_amdgcn_s_barrier(); asm volatile("" ::: "memory");
            const int t = (4 * wr + wc) * 64 + fq * 16 + fr, cb0 = (u.pn - (post == 1 ? 8 : post == 2 ? 4 : 0)) * 256;
            const int c = cb0 + (t & 31) * 8, rb = t >> 5, rowb = u.pm * BM + rb * 16;
            if (post == 3) {
                const bf16_t* zb = pin + (size_t)rowb * D + c; bf16_t* yb = pout + (size_t)rowb * D + c;
                if (u.pn == 0) pool_post<2>(zb, yb, rb); else if (u.pn == 1) pool_post<4>(zb, yb, rb); else if (u.pn == 2) pool_post<8>(zb, yb, rb); else pool_post<16>(zb, yb, rb);
            } else if (post == 1) {
                const bf16_t* zb = pin + (size_t)rowb * 3072 + c; bf16_t* yb = pout + (size_t)rowb * D + c;
                f32x4 w[3][2];
#pragma unroll
                for (int k = 0; k < 3; ++k) { w[k][0] = *(const f32x4*)(pw + k * 1024 + c); w[k][1] = *(const f32x4*)(pw + k * 1024 + c + 4); }
                float p2[8], p1[8];
#pragma unroll
                for (int j = 0; j < 8; ++j) { p2[j] = 0.f; p1[j] = 0.f; }
                if (rb > 0) { float a_[8], b_[8]; unpack8(*(const u32x4*)(zb - 2 * 3072 + 1024), a_); unpack8(*(const u32x4*)(zb - 2 * 3072 + 2048), b_);
#pragma unroll
                    for (int j = 0; j < 8; ++j) p2[j] = a_[j] * b_[j];
                    unpack8(*(const u32x4*)(zb - 3072 + 1024), a_); unpack8(*(const u32x4*)(zb - 3072 + 2048), b_);
#pragma unroll
                    for (int j = 0; j < 8; ++j) p1[j] = a_[j] * b_[j]; }
#pragma unroll
                for (int hf = 0; hf < 2; ++hf) {
                    u32x4 cv[8], xv[8], bv[8];
#pragma unroll
                    for (int i = 0; i < 8; ++i) { const bf16_t* zr = zb + (size_t)(hf * 8 + i) * 3072; bv[i] = *(const u32x4*)zr; cv[i] = *(const u32x4*)(zr + 1024); xv[i] = *(const u32x4*)(zr + 2048); }
#pragma unroll
                    for (int i = 0; i < 8; ++i) { float cf[8], xf[8], bf[8], o[8]; unpack8(cv[i], cf); unpack8(xv[i], xf); unpack8(bv[i], bf);
#pragma unroll
                        for (int j = 0; j < 8; ++j) { const float pr = cf[j] * xf[j]; o[j] = bf[j] * (w[0][j >> 2][j & 3] * p2[j] + (w[1][j >> 2][j & 3] * p1[j] + w[2][j >> 2][j & 3] * pr)); p2[j] = p1[j]; p1[j] = pr; }
                        *(u32x4*)(yb + (size_t)(hf * 8 + i) * D) = pack8(o); }
                }
            } else {
                const bf16_t* zb = pin + (size_t)rowb * D + c; bf16_t* yb = pout + (size_t)rowb * D + c;
                f32x4 w[4][2], bb[2];
#pragma unroll
                for (int k = 0; k < 4; ++k) { w[k][0] = *(const f32x4*)(pw + k * 1024 + c); w[k][1] = *(const f32x4*)(pw + k * 1024 + c + 4); }
                bb[0] = *(const f32x4*)(pb + c); bb[1] = *(const f32x4*)(pb + c + 4);
                float q3[8], q2[8], q1[8];
#pragma unroll
                for (int j = 0; j < 8; ++j) { q3[j] = 0.f; q2[j] = 0.f; q1[j] = 0.f; }
                if (rb > 0) { unpack8(*(const u32x4*)(zb - 3 * D), q3); unpack8(*(const u32x4*)(zb - 2 * D), q2); unpack8(*(const u32x4*)(zb - D), q1); }
#pragma unroll
                for (int hf = 0; hf < 2; ++hf) {
                    u32x4 zv[8];
#pragma unroll
                    for (int i = 0; i < 8; ++i) zv[i] = *(const u32x4*)(zb + (size_t)(hf * 8 + i) * D);
#pragma unroll
                    for (int i = 0; i < 8; ++i) { float zf[8], o[8]; unpack8(zv[i], zf);
#pragma unroll
                        for (int j = 0; j < 8; ++j) { o[j] = bb[j >> 2][j & 3] + w[0][j >> 2][j & 3] * q3[j] + (w[1][j >> 2][j & 3] * q2[j] + (w[2][j >> 2][j & 3] * q1[j] + w[3][j >> 2][j & 3] * zf[j])); q3[j] = q2[j]; q2[j] = q1[j]; q1[j] = zf[j]; }
                        *(u32x4*)(yb + (size_t)(hf * 8 + i) * D) = pack8(o); }
                }
            }
        }
    }
};

struct EpiRes {
    static constexpr bool PERM = true, ROWPERM = false;
    bf16_t* xb; float* ssn;
    __device__ __forceinline__ void operator()(const f32x4 (&acc)[2][2][4][2], const Unit& u, int wr, int wc, int fr, int fq) const {
        { const int l_ = lane_id_hw(); fr = l_ & 15; fq = l_ >> 4; }
        const int row0 = u.pm * BM + wr * 64 + fr, col0 = u.pn * BM + wc * 32 + 8 * fq;
        u32x4 xo[2][4][2];
#pragma unroll
        for (int ai = 0; ai < 2; ++ai)
#pragma unroll
            for (int m = 0; m < 4; ++m) { const size_t off = (size_t)(row0 + ai * HALF + m * 16) * D + col0;
#pragma unroll
                for (int bj = 0; bj < 2; ++bj) xo[ai][m][bj] = *(const u32x4*)(xb + off + bj * HALF); }
#pragma unroll
        for (int ai = 0; ai < 2; ++ai) {
#pragma unroll
            for (int m = 0; m < 4; ++m) { const int row = row0 + ai * HALF + m * 16; const size_t off = (size_t)row * D + col0; float sq = 0.f;
#pragma unroll
                for (int bj = 0; bj < 2; ++bj) {
                    float xf[8]; unpack8(xo[ai][m][bj], xf);
                    const f32x4 x0 = (f32x4){xf[0], xf[1], xf[2], xf[3]} + acc[ai][bj][m][0], x1 = (f32x4){xf[4], xf[5], xf[6], xf[7]} + acc[ai][bj][m][1];
                    sq += (x0[0] * x0[0] + x0[1] * x0[1]) + (x0[2] * x0[2] + x0[3] * x0[3]) + (x1[0] * x1[0] + x1[1] * x1[1]) + (x1[2] * x1[2] + x1[3] * x1[3]);
                    u32x4 w; w.x = cvt_pk_bf16(x0[0], x0[1]); w.y = cvt_pk_bf16(x0[2], x0[3]); w.z = cvt_pk_bf16(x1[0], x1[1]); w.w = cvt_pk_bf16(x1[2], x1[3]);
                    *(u32x4*)(xb + off + bj * HALF) = w; }
                sq += __shfl_xor(sq, 16); sq += __shfl_xor(sq, 32); if (fq == 0) ssn[(size_t)row * 16 + u.pn * 4 + wc] = sq; }
            asm volatile("" ::: "memory");
        }
    }
};

struct EpiResFinal {
    static constexpr bool PERM = true, ROWPERM = false;
    const bf16_t* xb; float* ssn; unsigned* cnt; float* out; const float* g; LAS float* R;
    __device__ __forceinline__ void operator()(f32x4 (&acc)[2][2][4][2], const Unit& u, int wr, int wc, int fr, int fq) const {
        { const int l_ = lane_id_hw(); fr = l_ & 15; fq = l_ >> 4; }
        const int row0 = u.pm * BM + wr * 64 + fr, col0 = u.pn * BM + wc * 32 + 8 * fq, wv = 4 * wr + wc;
        u32x4 xo[2][4][2];
#pragma unroll
        for (int ai = 0; ai < 2; ++ai)
#pragma unroll
            for (int m = 0; m < 4; ++m) { const size_t off = (size_t)(row0 + ai * HALF + m * 16) * D + col0;
#pragma unroll
                for (int bj = 0; bj < 2; ++bj) xo[ai][m][bj] = *(const u32x4*)(xb + off + bj * HALF); }
#pragma unroll
        for (int ai = 0; ai < 2; ++ai)
#pragma unroll
            for (int m = 0; m < 4; ++m) { const int row = row0 + ai * HALF + m * 16; float sq = 0.f;
#pragma unroll
                for (int bj = 0; bj < 2; ++bj) {
                    float xf[8]; unpack8(xo[ai][m][bj], xf);
                    const f32x4 x0 = (f32x4){xf[0], xf[1], xf[2], xf[3]} + acc[ai][bj][m][0], x1 = (f32x4){xf[4], xf[5], xf[6], xf[7]} + acc[ai][bj][m][1];
                    sq += (x0[0] * x0[0] + x0[1] * x0[1]) + (x0[2] * x0[2] + x0[3] * x0[3]) + (x1[0] * x1[0] + x1[1] * x1[1]) + (x1[2] * x1[2] + x1[3] * x1[3]);
                    acc[ai][bj][m][0] = x0; acc[ai][bj][m][1] = x1; }
                sq += __shfl_xor(sq, 16); sq += __shfl_xor(sq, 32);
                if (fq == 0) __hip_atomic_store(ssn + (size_t)row * 16 + u.pn * 4 + wc, sq, __ATOMIC_RELAXED, __HIP_MEMORY_SCOPE_AGENT); }
        asm volatile("s_waitcnt vmcnt(0)" ::: "memory"); __builtin_amdgcn_s_barrier(); asm volatile("" ::: "memory");
        if (wv == 0) {
            if (fq == 0 && fr == 0) __hip_atomic_fetch_add(cnt + u.pm, 1u, __ATOMIC_RELAXED, __HIP_MEMORY_SCOPE_AGENT);
            unsigned sp = 0;
            while ((unsigned)__builtin_amdgcn_readfirstlane((int)__hip_atomic_load(cnt + u.pm, __ATOMIC_RELAXED, __HIP_MEMORY_SCOPE_AGENT)) < 4u) { __builtin_amdgcn_s_sleep(1); if (++sp > (1u << 20)) break; }
            __builtin_amdgcn_fence(__ATOMIC_ACQUIRE, "agent");
            asm volatile("s_waitcnt vmcnt(0)" ::: "memory");
        }
        __builtin_amdgcn_s_barrier(); asm volatile("" ::: "memory");
        if (wv < 4) { const int r = wv * 64 + fq * 16 + fr; const float* pp = ssn + (size_t)(u.pm * BM + r) * 16; float q = 0.f;
#pragma unroll
            for (int k = 0; k < 16; ++k) q += __hip_atomic_load(pp + k, __ATOMIC_RELAXED, __HIP_MEMORY_SCOPE_AGENT);
            R[r] = rsqrtf(q * (1.0f / 1024.0f) + EPS); }
        asm volatile("s_waitcnt lgkmcnt(0)" ::: "memory"); __builtin_amdgcn_s_barrier(); asm volatile("" ::: "memory");
        *(volatile LAS int*)(R + 256) = -1;
        f32x4 gv[2][2];
#pragma unroll
        for (int bj = 0; bj < 2; ++bj) { gv[bj][0] = *(const f32x4*)(g + col0 + bj * HALF); gv[bj][1] = *(const f32x4*)(g + col0 + bj * HALF + 4); }
#pragma unroll
        for (int ai = 0; ai < 2; ++ai)
#pragma unroll
            for (int m = 0; m < 4; ++m) { const int rl = wr * 64 + fr + ai * HALF + m * 16; const float rs = R[rl]; float* op = out + (size_t)(u.pm * BM + rl) * D + col0;
#pragma unroll
                for (int bj = 0; bj < 2; ++bj) { *(f32x4*)(op + bj * HALF) = acc[ai][bj][m][0] * rs * gv[bj][0]; *(f32x4*)(op + bj * HALF + 4) = acc[ai][bj][m][1] * rs * gv[bj][1]; } }
    }
};

__device__ __forceinline__ float softplus_neg(float l) { const float e = __expf(-l); return (e < 0.03f) ? e * (1.0f - e * (0.5f - e * (0.33333333f - 0.25f * e))) : __logf(1.0f + e); }
__device__ __forceinline__ float one_minus_exp(float x) { return 1.0f - __expf(x); }
struct EpiGate {
    static constexpr bool PERM = true, ROWPERM = false;
    const bf16_t* xrc; const float* b_a; const float* b_i; const float* lam; unsigned* AB; float* Ls; float* Hs;
    __device__ __forceinline__ void operator()(const f32x4 (&acc)[2][2][4][2], const Unit& u, int wr, int wc, int fr, int fq) const {
        { const int l_ = lane_id_hw(); fr = l_ & 15; fq = l_ >> 4; }
        const int row0 = u.pm * BM + wr * 64 + fr, c0 = (u.pn >> 1) * 256 + (u.pn & 1) * 128 + wc * 32 + 8 * fq;
#pragma unroll
        for (int hf = 0; hf < 2; ++hf) {
            const f32x4 lv = *(const f32x4*)(lam + c0 + 4 * hf), bav = *(const f32x4*)(b_a + c0 + 4 * hf), biv = *(const f32x4*)(b_i + c0 + 4 * hf);
            f32x4 sp;
#pragma unroll
            for (int j = 0; j < 4; ++j) sp[j] = 8.0f * softplus_neg(lv[j]);
#pragma unroll
            for (int ai = 0; ai < 2; ++ai)
#pragma unroll
                for (int m = 0; m < 4; ++m) {
                    const int row = row0 + ai * HALF + m * 16; const size_t off = (size_t)row * D + c0 + 4 * hf;
                    const u32x2 xw = *(const u32x2*)(xrc + off); const float xr[4] = {bf_lo(xw.x), bf_hi(xw.x), bf_lo(xw.y), bf_hi(xw.y)};
                    u32x4 w;
#pragma unroll
                    for (int j2 = 0; j2 < 2; ++j2) { const int j = 2 * j2;
                        const f32x2v rp = (f32x2v){acc[ai][0][m][hf][j], acc[ai][0][m][hf][j + 1]} + (f32x2v){bav[j], bav[j + 1]}, ip = (f32x2v){acc[ai][1][m][hf][j], acc[ai][1][m][hf][j + 1]} + (f32x2v){biv[j], biv[j + 1]};
                        const f32x2v er = rp * (-1.4426950408889634f), ei = ip * (-1.4426950408889634f);
                        f32x2v tr, ti; tr.x = __builtin_amdgcn_exp2f(er.x); tr.y = __builtin_amdgcn_exp2f(er.y); ti.x = __builtin_amdgcn_exp2f(ei.x); ti.y = __builtin_amdgcn_exp2f(ei.y);
                        const f32x2v dr = tr + 1.0f, di = ti + 1.0f; f32x2v r, ig; r.x = __builtin_amdgcn_rcpf(dr.x); r.y = __builtin_amdgcn_rcpf(dr.y); ig.x = __builtin_amdgcn_rcpf(di.x); ig.y = __builtin_amdgcn_rcpf(di.y);
                        const f32x2v la = r * (f32x2v){-sp[j], -sp[j + 1]}, e2 = la * 2.8853900817779268f;
                        f32x2v a2; a2.x = __builtin_amdgcn_exp2f(e2.x); a2.y = __builtin_amdgcn_exp2f(e2.y);
                        const f32x2v om = __builtin_elementwise_max(1.0f - a2, (f32x2v){0.f, 0.f}); f32x2v mult; mult.x = __builtin_amdgcn_sqrtf(om.x); mult.y = __builtin_amdgcn_sqrtf(om.y);
                        const f32x2v bt = (mult * ig) * (f32x2v){xr[j], xr[j + 1]};
                        w[j] = pack_f16(la.x, bt.x); w[j + 1] = pack_f16(la.y, bt.y); }
                    *(u32x4*)(AB + off) = w;
                    asm volatile("" ::: "memory");
                }
        }
        asm volatile("s_waitcnt vmcnt(0)" ::: "memory"); __builtin_amdgcn_s_barrier(); asm volatile("" ::: "memory");
        { const int t = (4 * wr + wc) * 64 + fq * 16 + fr, chunk = t >> 7, c = (u.pn >> 1) * 256 + (u.pn & 1) * 128 + (t & 127), r0 = u.pm * BM + chunk * 64;
          const unsigned* ab = AB + (size_t)r0 * D + c; float h = 0.f, L = 0.f;
#pragma unroll
          for (int b4 = 0; b4 < 4; ++b4) { unsigned w[16];
#pragma unroll
              for (int i = 0; i < 16; ++i) w[i] = ab[(size_t)(b4 * 16 + i) * D];
#pragma unroll
              for (int i = 0; i < 16; ++i) { const float la = f16_lo(w[i]); h = __expf(la) * h + f16_hi(w[i]); L += la; } }
          const size_t o = (size_t)(r0 >> 6) * 1024 + c; Ls[o] = L; Hs[o] = h; }
    }
};

__device__ __forceinline__ float dpp_ror1(float v) { return __builtin_bit_cast(float, __builtin_amdgcn_mov_dpp(__builtin_bit_cast(int, v), 0x121, 0xf, 0xf, false)); }
__device__ __forceinline__ float dpp_ror2(float v) { return __builtin_bit_cast(float, __builtin_amdgcn_mov_dpp(__builtin_bit_cast(int, v), 0x122, 0xf, 0xf, false)); }
__device__ __forceinline__ float dpp_shr1(float old, float v) { return __builtin_bit_cast(float, __builtin_amdgcn_update_dpp(__builtin_bit_cast(int, old), __builtin_bit_cast(int, v), 0x111, 0xf, 0xf, false)); }
__device__ __forceinline__ float dpp_shr2(float old, float v) { return __builtin_bit_cast(float, __builtin_amdgcn_update_dpp(__builtin_bit_cast(int, old), __builtin_bit_cast(int, v), 0x112, 0xf, 0xf, false)); }
struct EpiFfn {
    static constexpr bool PERM = true, ROWPERM = true;
    bf16_t* A2; const float* ss; const float* cw; const float* cb; float* ZS; LAS float* H;
    __device__ __forceinline__ void operator()(f32x4 (&acc)[2][2][4][2], const Unit& u, int wr, int wc, int fr, int fq) const {
        { const int l_ = lane_id_hw(); fr = l_ & 15; fq = l_ >> 4; }
        const int rl0 = wr * 64 + 4 * fr, tcol = wc * 32 + 8 * fq, c0 = u.pn * 128 + tcol;
        LAS float* R = H + 3 * 2 * 256; LAS float* WL = R + 256 + 64;
        f32x2v wl2; int wl_idx;
        { const int t2 = ((4 * wr + wc) * 64 + fq * 16 + fr) * 2, k = t2 >> 8, tc = t2 & 255; wl_idx = t2;
          const float* src = (k < 3 ? cw + k * 5632 : cb) + (tc >> 7) * FFW + u.pn * 128 + (tc & 127); wl2 = *(const f32x2v*)src; }
        if (*(volatile LAS int*)(R + 256) != u.pm) {
            const int wv = 4 * wr + wc, l_ = lane_id_hw(); if (wv < 4) { const int r = wv * 64 + l_; R[r] = rsqrtf(sum16(ss + (size_t)(u.pm * BM + r) * 16) * (1.0f / 1024.0f) + EPS); }
            asm volatile("s_waitcnt lgkmcnt(0)" ::: "memory"); __builtin_amdgcn_s_barrier(); asm volatile("" ::: "memory");
            if (wv == 0 && l_ == 0) *(volatile LAS int*)(R + 256) = u.pm; }
#pragma unroll
        for (int ai = 0; ai < 2; ++ai) { const f32x4 rs4 = *(const LAS f32x4*)(R + rl0 + ai * HALF);
#pragma unroll
            for (int m = 0; m < 4; ++m)
#pragma unroll
                for (int bj = 0; bj < 2; ++bj) { acc[ai][bj][m][0] *= rs4[m]; acc[ai][bj][m][1] *= rs4[m]; } }
#pragma unroll
        for (int ai = 0; ai < 2; ++ai) { const int sl = 2 * ai + wr;
            if (fr == 15) {
#pragma unroll
                for (int k = 0; k < 2; ++k)
#pragma unroll
                    for (int bj = 0; bj < 2; ++bj)
#pragma unroll
                        for (int n = 0; n < 2; ++n) {
                            if (sl < 3) *(LAS f32x4*)(H + (sl * 2 + k) * 256 + bj * 128 + tcol + 4 * n) = acc[ai][bj][2 + k][n];
                            else *(f32x4*)(ZS + ((size_t)u.pm * 4 + 2 + k) * 5632 + bj * FFW + c0 + 4 * n) = acc[ai][bj][2 + k][n]; } }
            if (sl == 0 && fr == 0) {
#pragma unroll
                for (int k = 0; k < 2; ++k)
#pragma unroll
                    for (int bj = 0; bj < 2; ++bj)
#pragma unroll
                        for (int n = 0; n < 2; ++n) *(f32x4*)(ZS + ((size_t)u.pm * 4 + k) * 5632 + bj * FFW + c0 + 4 * n) = acc[ai][bj][k][n]; } }
        *(LAS f32x2v*)(WL + wl_idx) = wl2;
        asm volatile("s_waitcnt lgkmcnt(0)" ::: "memory"); __builtin_amdgcn_s_barrier(); asm volatile("" ::: "memory"); __builtin_amdgcn_sched_barrier(0);
        int rowb = u.pm * BM + rl0; asm volatile("" : "+v"(rowb));
#pragma unroll
        for (int hf = 0; hf < 2; ++hf) {
            __builtin_amdgcn_sched_barrier(0);
            const int c = c0 + 4 * hf;
            const LAS float* wl = WL + tcol + 4 * hf;
            const f32x4 wg0 = *(const LAS f32x4*)(wl), wg1 = *(const LAS f32x4*)(wl + 256), wg2 = *(const LAS f32x4*)(wl + 512), bg = *(const LAS f32x4*)(wl + 768);
            const f32x4 wv0 = *(const LAS f32x4*)(wl + 128), wv1 = *(const LAS f32x4*)(wl + 384), wv2 = *(const LAS f32x4*)(wl + 640), bvv = *(const LAS f32x4*)(wl + 896);
#pragma unroll
            for (int ai = 0; ai < 2; ++ai) { const int sl = 2 * ai + wr;
                f32x4 hg62 = (f32x4){0.f, 0.f, 0.f, 0.f}, hg63 = hg62, hv62 = hg62, hv63 = hg62;
                if (sl > 0) { const LAS float* hp = H + ((sl - 1) * 2) * 256 + tcol + 4 * hf; hg62 = *(const LAS f32x4*)hp; hv62 = *(const LAS f32x4*)(hp + 128); hg63 = *(const LAS f32x4*)(hp + 256); hv63 = *(const LAS f32x4*)(hp + 384); }
                f32x4 sg3, sg2, sv3, sv2;
#pragma unroll
                for (int j = 0; j < 4; ++j) { sg3[j] = dpp_shr1(hg63[j], acc[ai][0][3][hf][j]); sg2[j] = dpp_shr1(hg62[j], acc[ai][0][2][hf][j]); sv3[j] = dpp_shr1(hv63[j], acc[ai][1][3][hf][j]); sv2[j] = dpp_shr1(hv62[j], acc[ai][1][2][hf][j]); }
#pragma unroll
                for (int m = 0; m < 4; ++m) {
                    const f32x4 cg = acc[ai][0][m][hf], cv = acc[ai][1][m][hf];
                    const f32x4 g1v = (m == 0) ? sg3 : acc[ai][0][m == 0 ? 0 : m - 1][hf], g2v = (m == 0) ? sg2 : (m == 1) ? sg3 : acc[ai][0][m < 2 ? 0 : m - 2][hf];
                    const f32x4 v1v = (m == 0) ? sv3 : acc[ai][1][m == 0 ? 0 : m - 1][hf], v2v = (m == 0) ? sv2 : (m == 1) ? sv3 : acc[ai][1][m < 2 ? 0 : m - 2][hf];
                    float o[4];
#pragma unroll
                    for (int j2 = 0; j2 < 2; ++j2) {
                        const int j = 2 * j2;
                        const f32x2v g1 = {g1v[j], g1v[j + 1]}, g2 = {g2v[j], g2v[j + 1]}, v1 = {v1v[j], v1v[j + 1]}, v2 = {v2v[j], v2v[j + 1]};
                        const f32x2v c_g = {cg[j], cg[j + 1]}, c_v = {cv[j], cv[j + 1]};
                        const f32x2v gc = (f32x2v){wg0[j], wg0[j + 1]} * g2 + ((f32x2v){wg1[j], wg1[j + 1]} * g1 + ((f32x2v){wg2[j], wg2[j + 1]} * c_g + (f32x2v){bg[j], bg[j + 1]}));
                        const f32x2v vc = (f32x2v){wv0[j], wv0[j + 1]} * v2 + ((f32x2v){wv1[j], wv1[j + 1]} * v1 + ((f32x2v){wv2[j], wv2[j + 1]} * c_v + (f32x2v){bvv[j], bvv[j + 1]}));
                        const f32x2v e = gc * (-1.4426950408889634f); f32x2v t; t.x = __builtin_amdgcn_exp2f(e.x); t.y = __builtin_amdgcn_exp2f(e.y);
                        const f32x2v d = t + 1.0f; f32x2v r; r.x = __builtin_amdgcn_rcpf(d.x); r.y = __builtin_amdgcn_rcpf(d.y);
                        const f32x2v oo = (gc * r) * vc; o[j] = oo.x; o[j + 1] = oo.y; }
                    u32x2 w; w.x = cvt_pk_bf16(o[0], o[1]); w.y = cvt_pk_bf16(o[2], o[3]);
                    *(u32x2*)(A2 + (size_t)(rowb + ai * HALF + m) * FFW + c) = w; }
                __builtin_amdgcn_sched_barrier(0); }
        }
    }
};
}

struct TrJob { const float* W; const float* gain; bf16_t* dst; int ldw, sc0, nblk, K, drb, inter, r; bool found; };
__device__ __forceinline__ TrJob tr_select(const Params& p, bf16_t* WB, int it) {
    int r = it; bool found = false;
    int wi = 0, ldw = 0, sc0 = 0, nblk = 1, K = 64, drb = 0, inter = 0, gi = -1, goff = 0; size_t woff = 0, doff = 0;
#define JOB(wi_, woff_, ldw_, sc0_, ncols_, K_, doff_, drb_, inter_, gi_, goff_) if (!found) { const int ni = ((K_) / 64) * ((ncols_) / 32); if (r < ni) { wi = (wi_); woff = (size_t)(woff_); ldw = (ldw_); sc0 = (sc0_); nblk = (ncols_) / 32; K = (K_); doff = (size_t)(doff_); drb = (drb_); inter = (inter_); gi = (gi_); goff = (goff_); found = true; } else r -= ni; }
    JOB(2, 0, 4096, 0, 4096, 1024, O_A_IN, 0, 0, 1, 0)
    JOB(7, 0, 1024, 0, 1024, 2048, O_A_OUT, 0, 0, -1, 0)
    JOB(9, 0, 1024, 0, 1024, 1024, O_B_IN, 0, 0, 8, 0)
    for (int g = 0; g < 4; ++g) JOB(10, g * 65536, 256, 0, 256, 256, O_B_GRP + g * 65536, 0, 0, -1, 0)
    JOB(13, 0, 1024, 0, 1024, 1024, O_B_OUT, 0, 0, 12, 0)
    JOB(15, 0, 2048, 0, 2048, 1024, O_C_IN, 0, 0, 14, 0)
    for (int h = 0; h < 4; ++h) { JOB(19, h * 65536, 256, 0, 256, 256, O_C_GATE, h * 512, 1, -1, 0) JOB(21, h * 65536, 256, 0, 256, 256, O_C_GATE, h * 512 + 128, 1, -1, 0) }
    JOB(24, 0, 1024, 0, 1024, 1024, O_C_OUT, 0, 0, -1, 0)
    JOB(26, 0, 3072, 0, 3072, 1024, O_D_IN, 0, 0, 25, 0)
    JOB(28, 0, 1024, 0, 1024, 1024, O_D_OUT, 0, 0, -1, 0)
    for (int l = 0; l < 4; ++l) {
        JOB(30, (size_t)l * 1024 * 5632, 5632, 0, 2816, 1024, O_F + l * (F_UP_SZ + F_DN_SZ), 0, 1, 29, l * 1024)
        JOB(30, (size_t)l * 1024 * 5632, 5632, 2816, 2816, 1024, O_F + l * (F_UP_SZ + F_DN_SZ), 128, 1, 29, l * 1024)
        JOB(33, (size_t)l * 2816 * 1024, 1024, 0, 1024, 2816, O_F + l * (F_UP_SZ + F_DN_SZ) + F_UP_SZ, 0, 0, -1, 0)
    }
#undef JOB
    TrJob j; j.W = p.in[wi] + woff; j.gain = (gi >= 0) ? p.in[gi] + goff : nullptr; j.dst = WB + doff; j.ldw = ldw; j.sc0 = sc0; j.nblk = nblk; j.K = K; j.drb = drb; j.inter = inter; j.r = r; j.found = found;
    return j;
}
__device__ __forceinline__ void tr_load(const TrJob& j, float (&wv)[32], int lane) {
    const int kb = j.r / j.nblk, nb = j.r % j.nblk, k0 = 64 * kb, c0 = 32 * nb;
    const float* src = j.W + (size_t)(k0 + (lane >> 5)) * j.ldw + j.sc0 + c0 + (lane & 31);
#pragma unroll
    for (int i = 0; i < 32; ++i) wv[i] = src[(size_t)(2 * i) * j.ldw];
}
__device__ __forceinline__ void tr_store(const TrJob& j, const float (&wv)[32], LAS float* scr, int lane) {
    const int kb = j.r / j.nblk, nb = j.r % j.nblk, k0 = 64 * kb, c0 = 32 * nb;
#pragma unroll
    for (int i = 0; i < 32; ++i) { const int kk = 2 * i + (lane >> 5); scr[kk * 33 + (lane & 31)] = wv[i]; }
    asm volatile("s_waitcnt lgkmcnt(0)" ::: "memory");
    const int c = lane & 7;
    f32x4 g0 = (f32x4){1.f, 1.f, 1.f, 1.f}, g1 = g0;
    if (j.gain) { g0 = *(const f32x4*)(j.gain + k0 + 8 * c); g1 = *(const f32x4*)(j.gain + k0 + 8 * c + 4); }
#pragma unroll
    for (int q = 0; q < 4; ++q) { const int n = (lane >> 3) + 8 * q; const LAS float* s = scr + (8 * c) * 33 + n;
        const int crel = c0 + n; const int drow = j.drb + (j.inter ? ((crel >> 7) * 256 + (crel & 127)) : crel);
        u32x4 o; o.x = cvt_pk_bf16(s[0 * 33] * g0[0], s[1 * 33] * g0[1]); o.y = cvt_pk_bf16(s[2 * 33] * g0[2], s[3 * 33] * g0[3]); o.z = cvt_pk_bf16(s[4 * 33] * g1[0], s[5 * 33] * g1[1]); o.w = cvt_pk_bf16(s[6 * 33] * g1[2], s[7 * 33] * g1[3]);
        *(u32x4*)(j.dst + (size_t)drow * j.K + k0 + 8 * c) = o; }
    asm volatile("s_waitcnt lgkmcnt(0)" ::: "memory");
}

__device__ __forceinline__ void prologue_phase(const Params& p, LAS unsigned char* lds, const int tid, const int bx) {
    const int lane = tid & 63, wave = tid >> 6;
    const int gw = bx * 8 + wave, NGW = gridDim.x * 8;
    LAS float* scr = (LAS float*)(lds + wave * 16384);
    bf16_t* WB = (bf16_t*)(p.ws + WS_W);
    constexpr int TOTAL = (int)(O_END / 2048);
    {
        int it = gw; float cur[32], nxt[32]; TrJob job, jobn;
        if (it < TOTAL) { job = tr_select(p, WB, it); tr_load(job, cur, lane); }
        while (it < TOTAL) {
            const int itn = it + NGW; const bool hn = itn < TOTAL;
            if (hn) { jobn = tr_select(p, WB, itn); tr_load(jobn, nxt, lane); }
            tr_store(job, cur, scr, lane);
            if (hn) { job = jobn;
#pragma unroll
                for (int i = 0; i < 32; ++i) cur[i] = nxt[i]; }
            it = itn;
        }
    }
    const float* x = p.in[0]; bf16_t* xb = (bf16_t*)(p.ws + WS_XB); float* SS = (float*)(p.ws + WS_SS);
    for (int rowq = gw; rowq < M / 4; rowq += NGW) {
        f32x4 v[4][4];
#pragma unroll
        for (int q = 0; q < 4; ++q) { const f32x4* xr = (const f32x4*)(x + (size_t)(rowq * 4 + q) * D) + lane;
#pragma unroll
            for (int j = 0; j < 4; ++j) v[q][j] = xr[64 * j]; }
#pragma unroll
        for (int q = 0; q < 4; ++q) { const int row = rowq * 4 + q; u32x2* o = (u32x2*)(xb + (size_t)row * D) + lane; float s = 0.f;
#pragma unroll
            for (int j = 0; j < 4; ++j) { const f32x4 vv = v[q][j]; s += (vv[0] * vv[0] + vv[1] * vv[1]) + (vv[2] * vv[2] + vv[3] * vv[3]); u32x2 w; w.x = cvt_pk_bf16(vv[0], vv[1]); w.y = cvt_pk_bf16(vv[2], vv[3]); o[64 * j] = w; }
            s = wave_sum(s); if (lane < 16) SS[(size_t)row * 16 + lane] = (lane == 0) ? s : 0.f; }
    }
}

__device__ __forceinline__ void gmlp_gate_phase(const Params& p, LAS unsigned char* lds, bf16_t* U, const bf16_t* V, const float* ssv, const int tid, const int bx) {
    const int lane = tid & 63, wave = tid >> 6, fr = lane & 15, fq = lane >> 4;
    const float* w_s = p.in[5]; const float* b_s = p.in[6]; const float* gv = p.in[4];
    LAS bf16_t* Wm = (LAS bf16_t*)lds;
    LAS bf16_t* Vs = (LAS bf16_t*)(lds + 128 * 272);
    LAS float* Rv = (LAS float*)(lds + 128 * 272 + 128 * 516);
    for (int item = bx; item < 2048; item += gridDim.x) {
        const int chunk = item >> 3, g = (item >> 1) & 3, half = item & 1;
        const int tok0 = chunk * 128, colb = g * 512 + half * 256;
        {
            const float* pp = ssv + (size_t)(tok0 + (tid >> 2)) * 32 + (tid & 3) * 8; const f32x4 a = *(const f32x4*)pp, b = *(const f32x4*)(pp + 4);
            float q = ((a[0] + a[1]) + (a[2] + a[3])) + ((b[0] + b[1]) + (b[2] + b[3])); q += __shfl_xor(q, 1); q += __shfl_xor(q, 2);
            if ((tid & 3) == 0) Rv[tid >> 2] = rsqrtf(q * (1.0f / 2048.0f) + EPS); }
        __syncthreads();
#pragma unroll
        for (int i = 0; i < 4; ++i) { const int pc = tid + 512 * i, t = pc >> 4, s0 = (pc & 15) * 8;
            const f32x4 w0 = *(const f32x4*)(w_s + ((size_t)g * 128 + t) * 128 + s0), w1 = *(const f32x4*)(w_s + ((size_t)g * 128 + t) * 128 + s0 + 4);
            float f[8];
#pragma unroll
            for (int j = 0; j < 4; ++j) { f[j] = (s0 + j <= t) ? w0[j] * Rv[s0 + j] : 0.f; f[4 + j] = (s0 + 4 + j <= t) ? w1[j] * Rv[s0 + 4 + j] : 0.f; }
            *(LAS u32x4*)(Wm + t * 136 + s0) = pack8(f); }
#pragma unroll
        for (int i = 0; i < 8; ++i) { const int pc = tid + 512 * i, s = pc >> 5, d0 = (pc & 31) * 8;
            const u32x4 v = *(const u32x4*)(V + (size_t)(tok0 + s) * 2048 + colb + d0);
            LAS unsigned* dst = (LAS unsigned*)(Vs + s * 258 + d0); dst[0] = v.x; dst[1] = v.y; dst[2] = v.z; dst[3] = v.w; }
        __syncthreads();
        f32x4 acc[8][2]; u32x2 upre[8][2];
#pragma unroll
        for (int mb = 0; mb < 8; ++mb) { acc[mb][0] = (f32x4){0.f, 0.f, 0.f, 0.f}; acc[mb][1] = (f32x4){0.f, 0.f, 0.f, 0.f};
#pragma unroll
            for (int nb = 0; nb < 2; ++nb) upre[mb][nb] = *(const u32x2*)(U + (size_t)(tok0 + mb * 16 + fr) * 2048 + colb + wave * 32 + nb * 16 + 4 * fq); }
#pragma unroll
        for (int kk = 0; kk < 4; ++kk) {
            bf16x8 vf[2];
#pragma unroll
            for (int nb = 0; nb < 2; ++nb) { const int d = wave * 32 + nb * 16 + fr;
#pragma unroll
                for (int j = 0; j < 8; ++j) vf[nb][j] = (short)Vs[(kk * 32 + fq * 8 + j) * 258 + d]; }
#pragma unroll
            for (int mb = 0; mb < 8; ++mb) { if (32 * kk <= 16 * mb + 15) {
                const bf16x8 wf = *(const LAS bf16x8*)(Wm + (mb * 16 + fr) * 136 + kk * 32 + fq * 8);
                acc[mb][0] = __builtin_amdgcn_mfma_f32_16x16x32_bf16(vf[0], wf, acc[mb][0], 0, 0, 0);
                acc[mb][1] = __builtin_amdgcn_mfma_f32_16x16x32_bf16(vf[1], wf, acc[mb][1], 0, 0, 0); } }
        }
#pragma unroll
        for (int mb = 0; mb < 8; ++mb) { const int t = mb * 16 + fr; const float bs = b_s[g * 128 + t];
#pragma unroll
            for (int nb = 0; nb < 2; ++nb) { const int col = colb + wave * 32 + nb * 16 + 4 * fq;
                const f32x4 gg = *(const f32x4*)(gv + col); bf16_t* up = U + (size_t)(tok0 + t) * 2048 + col;
                const u32x2 uw = upre[mb][nb];
                const float o0 = bf_lo(uw.x) * (acc[mb][nb][0] * gg[0] + bs), o1 = bf_hi(uw.x) * (acc[mb][nb][1] * gg[1] + bs), o2 = bf_lo(uw.y) * (acc[mb][nb][2] * gg[2] + bs), o3 = bf_hi(uw.y) * (acc[mb][nb][3] * gg[3] + bs);
                u32x2 ow; ow.x = cvt_pk_bf16(o0, o1); ow.y = cvt_pk_bf16(o2, o3); *(u32x2*)up = ow; } }
        __syncthreads();
    }
}

__device__ __forceinline__ void ffn_gate_phase(const bf16_t* Zc, bf16_t* A2, const float* cw, const float* cb, int gtid, int NT) {
    constexpr int NCG = FFW / 8; const int total = 8192 * NCG;
    for (int idx = gtid; idx < total; idx += NT) {
        const int lr = idx / NCG, cgp = idx - lr * NCG, c = cgp * 8, zc = (c >> 7) * 256 + (c & 127), tseq = lr & (SEQ - 1);
        float g[8], v[8];
        { const f32x4 a0 = *(const f32x4*)(cb + c), a1 = *(const f32x4*)(cb + c + 4), b0 = *(const f32x4*)(cb + FFW + c), b1 = *(const f32x4*)(cb + FFW + c + 4);
#pragma unroll
          for (int j = 0; j < 4; ++j) { g[j] = a0[j]; g[4 + j] = a1[j]; v[j] = b0[j]; v[4 + j] = b1[j]; } }
#pragma unroll
        for (int k = 0; k < 3; ++k) { const int dt = 2 - k; if (tseq >= dt) {
            const bf16_t* zp = Zc + (size_t)(lr - dt) * 5632 + zc; float zg[8], zv[8]; unpack8(*(const u32x4*)zp, zg); unpack8(*(const u32x4*)(zp + 128), zv);
            const f32x4 wg0 = *(const f32x4*)(cw + k * 5632 + c), wg1 = *(const f32x4*)(cw + k * 5632 + c + 4), wv0 = *(const f32x4*)(cw + k * 5632 + FFW + c), wv1 = *(const f32x4*)(cw + k * 5632 + FFW + c + 4);
#pragma unroll
            for (int j = 0; j < 4; ++j) { g[j] += wg0[j] * zg[j]; g[4 + j] += wg1[j] * zg[4 + j]; v[j] += wv0[j] * zv[j]; v[4 + j] += wv1[j] * zv[4 + j]; } } }
        float o[8];
#pragma unroll
        for (int j = 0; j < 8; ++j) o[j] = siluf_(g[j]) * v[j];
        *(u32x4*)(A2 + (size_t)lr * FFW + c) = pack8(o);
    }
}

__device__ __forceinline__ void scan1_phase(const unsigned* AB, float* Ls, float* Hs, int gtid, int NT) {
    for (int idx = gtid; idx < 8 * 64 * 512; idx += NT) {
        const int cp = idx & 511, j = (idx >> 9) & 63, b = idx >> 15, c = 2 * cp; const size_t row0 = (size_t)b * SEQ + j * 64;
        float h0 = 0.f, h1 = 0.f, L0 = 0.f, L1 = 0.f;
#pragma unroll 8
        for (int i = 0; i < 64; ++i) { const u32x2 w = *(const u32x2*)(AB + (row0 + i) * D + c);
            const float la0 = f16_lo(w.x), la1 = f16_lo(w.y); h0 = __expf(la0) * h0 + f16_hi(w.x); h1 = __expf(la1) * h1 + f16_hi(w.y); L0 += la0; L1 += la1; }
        const size_t o = ((size_t)b * 64 + j) * 1024 + c; Ls[o] = L0; Ls[o + 1] = L1; Hs[o] = h0; Hs[o + 1] = h1;
    }
}
__device__ __forceinline__ void scan2_phase(const unsigned* AB, const float* Ls, const float* Hs, const bf16_t* G, bf16_t* Y, int gtid, int NT) {
    for (int idx = gtid; idx < 8 * 64 * 256; idx += NT) {
        const int cq = idx & 255, j = (idx >> 8) & 63, b = idx >> 14, c = 4 * cq; const size_t row0 = (size_t)b * SEQ + j * 64;
        f32x4 h = (f32x4){0.f, 0.f, 0.f, 0.f};
#pragma unroll 8
        for (int jj = 0; jj < j; ++jj) { const size_t o = ((size_t)b * 64 + jj) * 1024 + c; const f32x4 l = *(const f32x4*)(Ls + o), hh = *(const f32x4*)(Hs + o);
#pragma unroll
            for (int k = 0; k < 4; ++k) h[k] = __expf(l[k]) * h[k] + hh[k]; }
#pragma unroll
        for (int b4 = 0; b4 < 4; ++b4) {
            u32x4 w[16]; u32x2 gq[16];
#pragma unroll
            for (int i = 0; i < 16; ++i) { const size_t off = (row0 + b4 * 16 + i) * D + c; w[i] = *(const u32x4*)(AB + off); gq[i] = *(const u32x2*)(G + off); }
#pragma unroll
            for (int i = 0; i < 16; ++i) {
#pragma unroll
                for (int k = 0; k < 4; ++k) h[k] = __expf(f16_lo(w[i][k])) * h[k] + f16_hi(w[i][k]);
                u32x2 yo; yo.x = cvt_pk_bf16(h[0] * bf_lo(gq[i].x), h[1] * bf_hi(gq[i].x)); yo.y = cvt_pk_bf16(h[2] * bf_lo(gq[i].y), h[3] * bf_hi(gq[i].y));
                *(u32x2*)(Y + (row0 + b4 * 16 + i) * D + c) = yo; }
        }
    }
}

__device__ __forceinline__ void final_norm_phase(float* out, const bf16_t* xb, const float* ss, const float* g, const int tid, const int bx) {
    const int lane = tid & 63, gw = bx * 8 + (tid >> 6), NGW = gridDim.x * 8;
    const f32x4* gr = (const f32x4*)g + 2 * lane;
    const f32x4 g00 = gr[0], g01 = gr[1], g10 = gr[128], g11 = gr[129];
    for (int rowq = gw; rowq < M / 4; rowq += NGW) {
        float rs[4]; u32x4 xv[4][2];
#pragma unroll
        for (int q = 0; q < 4; ++q) { const int row = rowq * 4 + q; rs[q] = sum16(ss + (size_t)row * 16); const u32x4* xr = (const u32x4*)(xb + (size_t)row * D) + lane; xv[q][0] = xr[0]; xv[q][1] = xr[64]; }
#pragma unroll
        for (int q = 0; q < 4; ++q) { const int row = rowq * 4 + q; const float r = rsqrtf(rs[q] * (1.0f / 1024.0f) + EPS); f32x4* o = (f32x4*)(out + (size_t)row * D) + 2 * lane;
            float xf[8]; unpack8(xv[q][0], xf); o[0] = (f32x4){xf[0], xf[1], xf[2], xf[3]} * r * g00; o[1] = (f32x4){xf[4], xf[5], xf[6], xf[7]} * r * g01;
            unpack8(xv[q][1], xf); o[128] = (f32x4){xf[0], xf[1], xf[2], xf[3]} * r * g10; o[129] = (f32x4){xf[4], xf[5], xf[6], xf[7]} * r * g11; }
    }
}

#define XB_TMO      128
#define XB_XCNT(j)  (256  + 64 * (j))
#define XB_XSUB(j)  (1280 + 64 * (j))
#define XB_XGEN(j)  (2304 + 64 * (j))
#define XB_TOP      3328
#define XB_TOPGEN   3392
#define XCD_BAR_WORDS 3456
#define XB_SPIN_CAP (1u << 20)
__device__ __forceinline__ unsigned xb_ld(unsigned* p)              { return __hip_atomic_load(p, __ATOMIC_RELAXED, __HIP_MEMORY_SCOPE_AGENT); }
__device__ __forceinline__ unsigned xb_add(unsigned* p, unsigned v) { return __hip_atomic_fetch_add(p, v, __ATOMIC_RELAXED, __HIP_MEMORY_SCOPE_AGENT); }
__device__ __forceinline__ unsigned xb_xcc_id() { return (unsigned)__builtin_amdgcn_s_getreg((3 << 11) | 20) & 0xFu; }
#define XB_SPIN(cond, bar) do { unsigned _sp = 0; while (cond) { __builtin_amdgcn_s_sleep(1); \
    if ((++_sp & 255u) == 0u) { if (xb_ld(&(bar)[XB_TMO])) break; if (_sp > XB_SPIN_CAP) { atomicAdd(&(bar)[XB_TMO], 1u); break; } } } } while (0)
__device__ __forceinline__ void xcd_barrier_complete(unsigned* bar, unsigned x, unsigned& nloc, unsigned& nx) {
    const unsigned G = gridDim.x * gridDim.y * gridDim.z;
    unsigned sum, cnt, mine, sp = 0u;
    for (;;) {
        sum = 0u; cnt = 0u; mine = 0u;
#pragma unroll
        for (unsigned j = 0; j < 16; ++j) { const unsigned c = xb_ld(&bar[XB_XCNT(j)]); sum += c; cnt += (c > 0u) ? 1u : 0u; mine = (j == x) ? c : mine; }
        if (sum == G) break;
        __builtin_amdgcn_s_sleep(1);
        if ((++sp & 255u) == 0u) { if (xb_ld(&bar[XB_TMO])) break; if (sp > XB_SPIN_CAP) { atomicAdd(&bar[XB_TMO], 1u); break; } }
    }
    nloc = mine > 0u ? mine : 1u; nx = cnt > 0u ? cnt : 1u;
}
__device__ __forceinline__ void xcd_barrier(unsigned* bar, volatile LAS unsigned* st, const bool leader) {
    asm volatile("s_waitcnt vmcnt(0)" ::: "memory");
    __syncthreads();
    if (leader) {
        const unsigned x = xb_xcc_id();
        __builtin_amdgcn_s_waitcnt(0);
        unsigned nloc = st[0], nx = st[1];
        if (nloc == 0u) { xcd_barrier_complete(bar, x, nloc, nx); st[0] = nloc; st[1] = nx; }
        const unsigned old = xb_add(&bar[XB_XSUB(x)], 1u);
        const unsigned gen = old / nloc;
        if (old + 1u == (gen + 1u) * nloc) {
            __builtin_amdgcn_fence(__ATOMIC_RELEASE, "agent");
            asm volatile("s_waitcnt vmcnt(0)" ::: "memory");
            const unsigned og = xb_add(&bar[XB_TOP], 1u);
            const unsigned tg = og / nx;
            if (og + 1u == (tg + 1u) * nx) xb_add(&bar[XB_TOPGEN], 1u);
            else XB_SPIN(xb_ld(&bar[XB_TOPGEN]) == tg, bar);
            __builtin_amdgcn_fence(__ATOMIC_ACQUIRE, "agent");
            xb_add(&bar[XB_XGEN(x)], 1u);
            asm volatile("s_waitcnt vmcnt(0)" ::: "memory");
        } else {
            XB_SPIN(xb_ld(&bar[XB_XGEN(x)]) == gen, bar);
            __builtin_amdgcn_fence(__ATOMIC_ACQUIRE, "agent");
            asm volatile("s_waitcnt vmcnt(0)" ::: "memory");
        }
    }
    __syncthreads();
}

#ifndef KINDS
#define KINDS 31
#endif
enum { K_PROLOGUE = 0, K_GEMM_FFN, K_GEMM_Z, K_GEMM_RES, K_GEMM_GATE, K_GMLP, K_FFNGATE, K_POOL, K_CONV4, K_SCAN1, K_SCAN2, K_SHORTCONV, K_FINAL };
constexpr int NPHASES = 1 + 3 + 2 + 3 + 2 + 4 + 2 + 2 + 2;

__global__ void __launch_bounds__(NTHREADS) mega_fwd(Params p) {
    extern __shared__ __attribute__((aligned(16))) unsigned char lds_raw[];
    LAS unsigned char* lds = (LAS unsigned char*)lds_raw;
    cg::grid_group grid = cg::this_grid();
    const int NT = gridDim.x * NTHREADS, G = gridDim.x;
    const int wid_s = __builtin_amdgcn_readfirstlane((int)threadIdx.x >> 6);
    volatile LAS unsigned* bst = (volatile LAS unsigned*)(lds + 131072 + 512);
    if (threadIdx.x == 0) { bst[0] = 0u; bst[1] = 0u; (void)xb_add(&((unsigned*)(p.ws + WS_BAR))[XB_XCNT(xb_xcc_id())], 1u); }
    __syncthreads();
#define SSK(k) (SS + (size_t)(k) * M * 16)

#ifndef PROBE_PH
#define PROBE_PH 1000
#endif
#ifndef PROBE_REPS
#define PROBE_REPS 0
#endif
    for (int phx = 0; phx < NPHASES + PROBE_REPS; ++phx) {
        const int ph = (phx <= PROBE_PH) ? phx : ((phx - PROBE_PH <= PROBE_REPS) ? PROBE_PH : phx - PROBE_REPS);
        int tid = wid_s * 64 + lane_id_hw(); asm volatile("" : "+v"(tid));
        int bx = blockIdx.x; asm volatile("" : "+s"(bx));
        unsigned char* ws = p.ws; asm volatile("" : "+s"(ws));
        float* X = p.out; asm volatile("" : "+s"(X));
        const int gtid = bx * NTHREADS + tid;
        float* SS = (float*)(ws + WS_SS);
        bf16_t* WB = (bf16_t*)(ws + WS_W);
        bf16_t* xb = (bf16_t*)(ws + WS_XB);
        unsigned char* AR = ws + WS_ARENA;
        int seg, q = ph;
        if (q == 0) seg = 0;
        else if ((q -= 1) < 3) seg = 1;
        else if ((q -= 3) < 2) seg = 8;
        else if ((q -= 2) < 3) seg = 2;
        else if ((q -= 3) < 2) seg = 9;
        else if ((q -= 2) < 4) seg = 3;
        else if ((q -= 4) < 2) seg = 10;
        else if ((q -= 2) < 2) seg = 4;
        else if ((q -= 2) < 2) seg = 11;
        else seg = 5;
        int kind;
        if (seg == 0) kind = K_PROLOGUE;
        else if (seg == 1) kind = (q == 0) ? K_GEMM_Z : (q == 1) ? K_GMLP : K_GEMM_RES;
        else if (seg == 2) kind = (q == 0) ? K_GEMM_Z : (q == 1) ? K_GEMM_Z : K_GEMM_RES;
        else if (seg == 3) kind = (q == 0) ? K_GEMM_Z : (q == 1) ? K_GEMM_GATE : (q == 2) ? K_SCAN2 : K_GEMM_RES;
        else if (seg == 4) kind = (q == 0) ? K_GEMM_Z : K_GEMM_RES;
        else if (seg == 5) kind = K_FINAL;
        else kind = (q == 0) ? K_GEMM_FFN : K_GEMM_RES;
        const int fl = seg - 8;

        if (kind == K_PROLOGUE) prologue_phase(p, lds, tid, bx);
        else if (kind == K_GEMM_FFN) {
            pg8::Gemm g{xb, WB + O_F + fl * (F_UP_SZ + F_DN_SZ), D, D, 128, 22, 0, 0};
            pg8::EpiFfn ef{(bf16_t*)AR, SSK(2 * fl + 1), p.in[31] + (size_t)fl * 3 * 5632, p.in[32] + (size_t)fl * 5632, (float*)(AR + 176 * MiB), (LAS float*)(lds + 131072 + 1024)};
            pg8::StaticOrder S; S.init(128, 22, G, bx, FFN_WGM);
            pg8::gemm_phase(lds, g, S, ef, tid);
        }
#if KINDS & 1
        else if (kind == K_GEMM_Z) {
            size_t a_off = WS_XB, w_off = 0, o_off = WS_ARENA, split_stride = 0; int lda = D, K = D, nM = 128, nN = 4, astep = 0, ldc = D, bias_i = -1, split_cols = 0, ss_k = -1, ss_row = 0, act_pn = 0, ssv_on = 0, post = 0;
            if (seg == 1) { w_off = O_A_IN; nN = 16; ldc = 2048; bias_i = 3; split_cols = 2048; split_stride = (size_t)64 * MiB; ss_k = 0; act_pn = 16; ssv_on = 1; }
            else if (seg == 2 && q == 0) { w_off = O_B_IN; ss_k = 2; post = 3; }
            else if (seg == 2) { a_off = WS_ARENA + 64 * MiB; w_off = O_B_GRP; K = 256; astep = 256; o_off = WS_ARENA + 128 * MiB; bias_i = 11; }
            else if (seg == 3) { w_off = O_C_IN; nN = 8; bias_i = 16; split_cols = 1024; split_stride = (size_t)32 * MiB; ss_k = 4; act_pn = 4; post = 2; }
            else { w_off = O_D_IN; nN = 12; ldc = 3072; ss_k = 6; post = 1; }
            pg8::Gemm g{(const bf16_t*)(ws + a_off), WB + w_off, lda, K, nM, nN, 0, astep};
            pg8::EpiZ ez{(bf16_t*)(ws + o_off), ldc, bias_i >= 0 ? p.in[bias_i] : nullptr, split_cols, split_stride, ss_k >= 0 ? SSK(ss_k) + (size_t)ss_row * 16 : nullptr, act_pn, ssv_on ? (float*)(ws + WS_SSV) : nullptr, 8, (LAS float*)(lds + 131072 + 1024 + 6144),
                         post, post == 2 ? (const bf16_t*)(AR + 64 * MiB) : (const bf16_t*)AR, post == 1 ? (bf16_t*)(AR + 192 * MiB) : post == 2 ? (bf16_t*)(AR + 128 * MiB) : (bf16_t*)(AR + 64 * MiB), post == 1 ? p.in[27] : p.in[17], p.in[18]};
            pg8::StaticOrder S; S.init(nM, nN, G, bx);
            if (seg == 2 && q == 1) {
                pg8::Unit uu;
                for (int i = 0; S.next(i, uu); ++i) { if ((uu.pm & 15) == 0) continue;
                    const int win = 2 << uu.pn, r = tid >> 5;
                    if (r < win - 1) pool_item((const bf16_t*)AR, (bf16_t*)(AR + 64 * MiB), uu.pm * 256 + r, uu.pn * 256 + (tid & 31) * 8, win, (uu.pm * 256 + r) & (SEQ - 1)); }
                asm volatile("s_waitcnt vmcnt(0)" ::: "memory"); __syncthreads();
            }
            pg8::gemm_phase(lds, g, S, ez, tid);
        }
#endif
#if KINDS & 2
        else if (kind == K_GEMM_RES) {
            size_t a_off = WS_ARENA, w_off = O_A_OUT; int K = D, ssn = 1;
            if (seg == 1) { K = 2048; }
            else if (seg == 2) { a_off = WS_ARENA + 128 * MiB; w_off = O_B_OUT; ssn = 3; }
            else if (seg == 3) { a_off = WS_ARENA + 64 * MiB; w_off = O_C_OUT; ssn = 5; }
            else if (seg == 4) { a_off = WS_ARENA + 192 * MiB; w_off = O_D_OUT; ssn = 7; }
            else { a_off = WS_ARENA; w_off = O_F + fl * (F_UP_SZ + F_DN_SZ) + F_UP_SZ; K = FFW; ssn = 2 * fl + 2; }
            pg8::Gemm g{(const bf16_t*)(ws + a_off), WB + w_off, K, K, 128, 4, 0, 0};
            pg8::EpiRes er{xb, SSK(ssn)};
            pg8::StaticOrder S; S.init(128, 4, G, bx);
            if (seg == 4) {
                pg8::Unit uu;
                for (int i = 0; S.next(i, uu); ++i) { if ((uu.pm & 15) == 0) continue;
                    if (tid < 256) shortconv_item((const bf16_t*)AR, (bf16_t*)(AR + 192 * MiB), p.in[27], uu.pm * 256 + (tid >> 7), (tid & 127) * 8, 2); }
                asm volatile("s_waitcnt vmcnt(0)" ::: "memory"); __syncthreads();
            }
            if (seg >= 8) {
                const float* ZS = (const float*)(AR + 176 * MiB); bf16_t* A2 = (bf16_t*)AR; const float* cw = p.in[31] + (size_t)fl * 3 * 5632; const float* cb = p.in[32] + (size_t)fl * 5632;
                pg8::Unit uu;
                for (int i = 0; S.next(i, uu); ++i) { if ((uu.pm & 15) == 0) continue;
                    for (int idx = tid; idx < 2 * 704; idx += NTHREADS) { const int r = idx / 704, c = (idx - r * 704) * 4;
                        f32x4 gsum = *(const f32x4*)(cb + c), vsum = *(const f32x4*)(cb + FFW + c);
#pragma unroll
                        for (int k = 0; k < 3; ++k) { const int j = r - 2 + k; const float* zr = (j < 0) ? ZS + ((size_t)(uu.pm - 1) * 4 + 4 + j) * 5632 : ZS + ((size_t)uu.pm * 4 + j) * 5632;
                            gsum += *(const f32x4*)(cw + k * 5632 + c) * *(const f32x4*)(zr + c); vsum += *(const f32x4*)(cw + k * 5632 + FFW + c) * *(const f32x4*)(zr + FFW + c); }
                        u32x2 w; w.x = cvt_pk_bf16(siluf_(gsum[0]) * vsum[0], siluf_(gsum[1]) * vsum[1]); w.y = cvt_pk_bf16(siluf_(gsum[2]) * vsum[2], siluf_(gsum[3]) * vsum[3]);
                        *(u32x2*)(A2 + (size_t)(uu.pm * 256 + r) * FFW + c) = w; } }
                asm volatile("s_waitcnt vmcnt(0)" ::: "memory"); __syncthreads();
            }
            if (seg == 11) {
                pg8::EpiResFinal ef{xb, SSK(8), (unsigned*)(ws + WS_BAR) + 3584, X, p.in[34], (LAS float*)(lds + 131072 + 1024 + 6144)};
                pg8::gemm_phase(lds, g, S, ef, tid);
            } else
            pg8::gemm_phase(lds, g, S, er, tid);
        }
#endif
#if KINDS & 4
        else if (kind == K_GEMM_GATE) {
            pg8::Gemm g{(bf16_t*)(AR + 128 * MiB), WB + O_C_GATE, D, 256, 128, 8, 1, 256};
            pg8::EpiGate eg{(const bf16_t*)(AR + 128 * MiB), p.in[20], p.in[22], p.in[23], (unsigned*)(AR + 192 * MiB), (float*)(ws + WS_SCAN), (float*)(ws + WS_SCAN) + 8 * 64 * 1024};
            pg8::StaticOrder S; S.init(g.nM, g.nN, G, bx);
            {
                pg8::Unit uu;
                for (int i = 0; S.next(i, uu); ++i) { if ((uu.pm & 15) == 0) continue;
                    if (tid < 96) conv4_item((const bf16_t*)(AR + 64 * MiB), (bf16_t*)(AR + 128 * MiB), p.in[17], p.in[18], uu.pm * 256 + (tid >> 5), (uu.pn >> 1) * 256 + (tid & 31) * 8, 3); }
                asm volatile("s_waitcnt vmcnt(0)" ::: "memory"); __syncthreads();
            }
            pg8::gemm_phase(lds, g, S, eg, tid);
        }
#endif
#if KINDS & 8
        else if (kind == K_GMLP) gmlp_gate_phase(p, lds, (bf16_t*)AR, (const bf16_t*)(AR + 128 * MiB), (const float*)(ws + WS_SSV), tid, bx);
#endif
#if KINDS & 16
        else if (kind == K_SCAN2) scan2_phase((const unsigned*)(AR + 192 * MiB), (const float*)(ws + WS_SCAN), (const float*)(ws + WS_SCAN) + 8 * 64 * 1024, (const bf16_t*)AR, (bf16_t*)(AR + 64 * MiB), gtid, NT);
#endif
        if (wid_s == 0 && lane_id_hw() == 0) *(volatile LAS int*)(lds + 131072 + 1024 + 6144 + 1024) = -1;
        if (p.out == nullptr) { asm volatile("s_waitcnt vmcnt(0)" ::: "memory"); grid.sync(); }
        else if (phx + 1 < NPHASES + PROBE_REPS) xcd_barrier((unsigned*)(p.ws + WS_BAR), bst, wid_s == 0 && lane_id_hw() == 0);
    }
}

extern "C" void kernel_launch(void* const* d_in, const int* in_sizes, int n_in, void* d_out, int out_size, void* d_ws, size_t ws_size, hipStream_t stream) {
    static int grid = 0;
    if (grid == 0) {
        if (n_in != 35 || out_size != M * D || ws_size < WS_NEED) { fprintf(stderr, "kernel_launch: unexpected shapes: n_in %d out %d ws %zu\n", n_in, out_size, ws_size); grid = -1; return; }
        int dev = 0, cus = 0, per_cu = 0;
        (void)hipGetDevice(&dev); (void)hipDeviceGetAttribute(&cus, hipDeviceAttributeMultiprocessorCount, dev);
        if (hipFuncSetAttribute((const void*)mega_fwd, hipFuncAttributeMaxDynamicSharedMemorySize, LDS_BYTES) != hipSuccess) { fprintf(stderr, "kernel_launch: hipFuncSetAttribute failed\n"); grid = -1; return; }
        if (hipOccupancyMaxActiveBlocksPerMultiprocessor(&per_cu, (const void*)mega_fwd, NTHREADS, LDS_BYTES) != hipSuccess || per_cu < 1) { fprintf(stderr, "kernel_launch: occupancy query says %d\n", per_cu); per_cu = 1; }
        (void)hipGetLastError();
        grid = cus;
        if (cus != 256) { fprintf(stderr, "kernel_launch: built for a 256-CU device (fused conv stages rely on the 256-workgroup unit order), found %d\n", cus); grid = -1; return; }
        fprintf(stderr, "kernel_launch: grid %d (per_cu %d)\n", grid, per_cu);
    }
    if (grid < 0) return;
    if (hipMemsetAsync((char*)d_ws + WS_BAR, 0, 16384, stream) != hipSuccess) { fprintf(stderr, "kernel_launch: memset failed\n"); return; }
    Params p{};
    for (int i = 0; i < 35; ++i) p.in[i] = (const float*)d_in[i];
    p.out = (float*)d_out; p.ws = (unsigned char*)d_ws;
    void* args[] = {&p};
    hipError_t e = hipLaunchCooperativeKernel((const void*)mega_fwd, dim3(grid), dim3(NTHREADS), args, LDS_BYTES, stream);
    if (e != hipSuccess) fprintf(stderr, "kernel_launch: cooperative launch failed: %s\n", hipGetErrorString(e));
}
```

```cpp
#include <hip/hip_runtime.h>
#include <hip/hip_cooperative_groups.h>
#include <cstdio>
#include <cstdint>
namespace cg = cooperative_groups;

#define LAS __attribute__((address_space(3)))
typedef unsigned short bf16_t;
typedef short bf16x8 __attribute__((ext_vector_type(8)));
typedef float f32x4 __attribute__((ext_vector_type(4)));
typedef unsigned u32x4 __attribute__((ext_vector_type(4)));
typedef unsigned u32x2 __attribute__((ext_vector_type(2)));
typedef float f32x2v __attribute__((ext_vector_type(2)));

constexpr int M = 32768, D = 1024, SEQ = 4096;
constexpr int FFW = 2816;
constexpr float EPS = 1e-6f;
constexpr int NTHREADS = 512;
#ifndef FFN_WGM
#define FFN_WGM 4
#endif
constexpr int LDS_BYTES = 147456;
constexpr size_t MiB = 1u << 20;

constexpr size_t WS_SS = 0;
constexpr size_t WS_SSV = 18 * MiB;
constexpr size_t WS_SCAN = 22 * MiB;
constexpr size_t WS_W = 26 * MiB;
constexpr size_t WS_XB = 124 * MiB;
constexpr size_t WS_ARENA = 188 * MiB;
constexpr size_t WS_BAR = 123 * MiB + 768 * 1024;
constexpr size_t WS_NEED = 512 * MiB;

constexpr size_t O_A_IN = 0;
constexpr size_t O_A_OUT = O_A_IN + (size_t)4096 * 1024;
constexpr size_t O_B_IN = O_A_OUT + (size_t)1024 * 2048;
constexpr size_t O_B_GRP = O_B_IN + (size_t)1024 * 1024;
constexpr size_t O_B_OUT = O_B_GRP + (size_t)4 * 256 * 256;
constexpr size_t O_C_IN = O_B_OUT + (size_t)1024 * 1024;
constexpr size_t O_C_GATE = O_C_IN + (size_t)2048 * 1024;
constexpr size_t O_C_OUT = O_C_GATE + (size_t)2048 * 256;
constexpr size_t O_D_IN = O_C_OUT + (size_t)1024 * 1024;
constexpr size_t O_D_OUT = O_D_IN + (size_t)3072 * 1024;
constexpr size_t O_F = O_D_OUT + (size_t)1024 * 1024;
constexpr size_t F_UP_SZ = (size_t)5632 * 1024, F_DN_SZ = (size_t)1024 * 2816;
constexpr size_t O_END = O_F + 4 * (F_UP_SZ + F_DN_SZ);
static_assert(WS_W + O_END * 2 <= WS_BAR && WS_BAR + 16384 <= WS_XB, "weights fit");

struct Params { const float* in[35]; float* out; unsigned char* ws; };

__device__ __forceinline__ unsigned cvt_pk_bf16(float lo, float hi) { unsigned r; asm("v_cvt_pk_bf16_f32 %0, %1, %2" : "=v"(r) : "v"(lo), "v"(hi)); return r; }
__device__ __forceinline__ float bf_lo(unsigned w) { return __uint_as_float(w << 16); }
__device__ __forceinline__ float bf_hi(unsigned w) { return __uint_as_float(w & 0xffff0000u); }
__device__ __forceinline__ void unpack8(const u32x4 w, float (&f)[8]) { f[0] = bf_lo(w.x); f[1] = bf_hi(w.x); f[2] = bf_lo(w.y); f[3] = bf_hi(w.y); f[4] = bf_lo(w.z); f[5] = bf_hi(w.z); f[6] = bf_lo(w.w); f[7] = bf_hi(w.w); }
__device__ __forceinline__ u32x4 pack8(const float (&f)[8]) { u32x4 w; w.x = cvt_pk_bf16(f[0], f[1]); w.y = cvt_pk_bf16(f[2], f[3]); w.z = cvt_pk_bf16(f[4], f[5]); w.w = cvt_pk_bf16(f[6], f[7]); return w; }
__device__ __forceinline__ float sigmoidf_(float x) { return 1.0f / (1.0f + __expf(-x)); }
__device__ __forceinline__ float gelu_tanh(float x) { const float u = 1.5957691216057308f * (x + 0.044715f * x * x * x); return x * sigmoidf_(u); }
__device__ __forceinline__ float siluf_(float x) { return x * sigmoidf_(x); }
__device__ __forceinline__ f32x2v gelu_tanh_pk(f32x2v x) {
    const f32x2v x2 = x * x, u = x * (x2 * 0.044715f + 1.0f), e = u * (-2.3022082f);
    f32x2v t; t.x = __builtin_amdgcn_exp2f(e.x); t.y = __builtin_amdgcn_exp2f(e.y);
    const f32x2v d = t + 1.0f; f32x2v r; r.x = __builtin_amdgcn_rcpf(d.x); r.y = __builtin_amdgcn_rcpf(d.y);
    return x * r; }
__device__ __forceinline__ unsigned pack_f16(float lo, float hi) { const _Float16 a = (_Float16)lo, b = (_Float16)hi; return (unsigned)__builtin_bit_cast(unsigned short, a) | ((unsigned)__builtin_bit_cast(unsigned short, b) << 16); }
__device__ __forceinline__ float f16_lo(unsigned w) { return (float)__builtin_bit_cast(_Float16, (unsigned short)(w & 0xffffu)); }
__device__ __forceinline__ float f16_hi(unsigned w) { return (float)__builtin_bit_cast(_Float16, (unsigned short)(w >> 16)); }
__device__ __forceinline__ int lane_id_hw() { int l; asm volatile("v_mbcnt_lo_u32_b32 %0, -1, 0\n\tv_mbcnt_hi_u32_b32 %0, -1, %0" : "=v"(l)); return l; }
__device__ __forceinline__ float wave_sum(float v) {
#pragma unroll
    for (int o = 1; o < 64; o <<= 1) v += __shfl_xor(v, o);
    return v;
}

__device__ __forceinline__ float sum16(const float* p) { const f32x4 a = *(const f32x4*)p, b = *(const f32x4*)(p + 4), c = *(const f32x4*)(p + 8), d = *(const f32x4*)(p + 12);
    return ((a[0] + a[1]) + (a[2] + a[3])) + ((b[0] + b[1]) + (b[2] + b[3])) + (((c[0] + c[1]) + (c[2] + c[3])) + ((d[0] + d[1]) + (d[2] + d[3]))); }

__device__ __forceinline__ void conv4_item(const bf16_t* XR, bf16_t* XRc, const float* cw, const float* cb, int row, int c, int tlim) {
    float a[8];
    { const f32x4 b0 = *(const f32x4*)(cb + c), b1 = *(const f32x4*)(cb + c + 4);
#pragma unroll
      for (int j = 0; j < 4; ++j) { a[j] = b0[j]; a[4 + j] = b1[j]; } }
#pragma unroll
    for (int k = 0; k < 4; ++k) { const int dt = 3 - k; if (tlim >= dt) { float z[8]; unpack8(*(const u32x4*)(XR + (size_t)(row - dt) * D + c), z);
        const f32x4 w0 = *(const f32x4*)(cw + k * 1024 + c), w1 = *(const f32x4*)(cw + k * 1024 + c + 4);
#pragma unroll
        for (int j = 0; j < 4; ++j) { a[j] += w0[j] * z[j]; a[4 + j] += w1[j] * z[4 + j]; } } }
    *(u32x4*)(XRc + (size_t)row * D + c) = pack8(a);
}
__device__ __forceinline__ void shortconv_item(const bf16_t* Z, bf16_t* Y, const float* cw, int row, int c, int tlim) {
    float a[8];
#pragma unroll
    for (int j = 0; j < 8; ++j) a[j] = 0.f;
#pragma unroll
    for (int k = 0; k < 3; ++k) { const int dt = 2 - k; if (tlim >= dt) { const bf16_t* zp = Z + (size_t)(row - dt) * 3072 + c; float cgv[8], xv[8]; unpack8(*(const u32x4*)(zp + 1024), cgv); unpack8(*(const u32x4*)(zp + 2048), xv);
        const f32x4 w0 = *(const f32x4*)(cw + k * 1024 + c), w1 = *(const f32x4*)(cw + k * 1024 + c + 4);
#pragma unroll
        for (int j = 0; j < 4; ++j) { a[j] += w0[j] * (cgv[j] * xv[j]); a[4 + j] += w1[j] * (cgv[4 + j] * xv[4 + j]); } } }
    float bg[8]; unpack8(*(const u32x4*)(Z + (size_t)row * 3072 + c), bg);
#pragma unroll
    for (int j = 0; j < 8; ++j) a[j] *= bg[j];
    *(u32x4*)(Y + (size_t)row * D + c) = pack8(a);
}

__device__ __forceinline__ void pool_item(const bf16_t* Z, bf16_t* P, int row, int c, int win, int tseq) {
    const int cnt = (tseq + 1 < win) ? tseq + 1 : win;
    float s[8], z0[8];
    unpack8(*(const u32x4*)(Z + (size_t)row * D + c), z0);
#pragma unroll
    for (int j = 0; j < 8; ++j) s[j] = z0[j];
    for (int i = 1; i < cnt; ++i) { float z[8]; unpack8(*(const u32x4*)(Z + (size_t)(row - i) * D + c), z);
#pragma unroll
        for (int j = 0; j < 8; ++j) s[j] += z[j]; }
    const float inv = 1.0f / (float)cnt; float o[8];
#pragma unroll
    for (int j = 0; j < 8; ++j) o[j] = s[j] * inv - z0[j];
    *(u32x4*)(P + (size_t)row * D + c) = pack8(o);
}
template <int WIN>
__device__ __forceinline__ void pool_post(const bf16_t* zb, bf16_t* yb, int rb) {
    u32x4 zv[16 + WIN - 1];
    if (rb > 0) {
#pragma unroll
        for (int i = 0; i < WIN - 1; ++i) zv[i] = *(const u32x4*)(zb + (ptrdiff_t)(i - (WIN - 1)) * D); }
#pragma unroll
    for (int i = 0; i < 16; ++i) zv[WIN - 1 + i] = *(const u32x4*)(zb + (size_t)i * D);
    float S[8];
#pragma unroll
    for (int j = 0; j < 8; ++j) S[j] = 0.f;
    if (rb > 0) {
#pragma unroll
        for (int i = 0; i < WIN - 1; ++i) { float z[8]; unpack8(zv[i], z);
#pragma unroll
            for (int j = 0; j < 8; ++j) S[j] += z[j]; } }
#pragma unroll
    for (int r = 0; r < 16; ++r) { float z[8], o[8]; unpack8(zv[WIN - 1 + r], z);
        const float inv = (rb > 0 || r + 1 >= WIN) ? (1.0f / (float)WIN) : (1.0f / (float)(r + 1));
#pragma unroll
        for (int j = 0; j < 8; ++j) { S[j] += z[j]; o[j] = S[j] * inv - z[j]; }
        *(u32x4*)(yb + (size_t)r * D) = pack8(o);
        if (rb > 0 || r + 1 >= WIN) { float zo[8]; unpack8(zv[r], zo);
#pragma unroll
            for (int j = 0; j < 8; ++j) S[j] -= zo[j]; } }
}

namespace pg8 {
constexpr int BM = 256, BK = 64, HALF = 128, HTB = HALF * BK * 2, STAGE_BYTES = 8 * HTB, NXCD = 8, WGM = 8;
__device__ __forceinline__ int lds_byte(int r, int c) { const int st = (r >> 4) * 2 + (c >> 5), rr = r & 15, cc = c & 31, ob = rr * 64 + cc * 2; return st * 1024 + (ob ^ (((ob >> 9) & 1) << 5)); }
__device__ __forceinline__ void stage_rc(int b, int& R, int& C) { const int st = b / 1024, sb = b % 1024, swz = sb ^ (((sb >> 9) & 1) << 5); R = (st >> 1) * 16 + swz / 64; C = (st & 1) * 32 + (swz % 64) / 2; }
__device__ __forceinline__ int perm32(int rho) { const int n = rho >> 4, i = rho & 15; return 8 * (i >> 2) + 4 * n + (i & 3); }

struct Unit { int pm, pn; };
struct Gemm { const bf16_t* A; const bf16_t* Bt; int lda, K, nM, nN, ashift, astep; };

struct StaticOrder {
    int nM, nN, nwg, G, c, wgm;
    __device__ void init(int nM_, int nN_, int G_, int c_, int wgm_ = WGM) { nM = nM_; nN = nN_; nwg = nM * nN; G = G_; c = c_; wgm = wgm_; }
    __device__ bool next(int i, Unit& u) const {
        const long L = (long)i * G + c; if (L >= nwg) return false;
        int wgid = (int)L; { const int q = nwg / NXCD, r = nwg % NXCD, xcd = wgid % NXCD, off = wgid / NXCD; wgid = (xcd < r ? xcd * (q + 1) : r * (q + 1) + (xcd - r) * q) + off; }
        const int nig = wgm * nN, gid = wgid / nig, fm = gid * wgm, gsz = (nM - fm) < wgm ? (nM - fm) : wgm;
        u.pm = fm + ((wgid % nig) % gsz); u.pn = (wgid % nig) / gsz; return true;
    }
};

template <class Epi>
__device__ __forceinline__ void gemm_phase(LAS unsigned char* lds, const Gemm g, const StaticOrder& S, const Epi& E, const int tid) {
    const int wid = __builtin_amdgcn_readfirstlane(tid >> 6), lane = tid & 63, wr = wid >> 2, wc = wid & 3, fr = lane & 15, fq = lane >> 4;
    int K = g.K, lda = g.lda; asm volatile("" : "+s"(K), "+s"(lda));
    const int nt = K / BK;
    unsigned voffA[2], voffB[2];
#pragma unroll
    for (int i = 0; i < 2; ++i) { int R, C; stage_rc(tid * 16 + i * 8192, R, C); const int Rb = Epi::PERM ? ((R & ~31) + perm32(R & 31)) : R;
        const int Ra = Epi::ROWPERM ? ((R & ~63) | ((R & 15) << 2) | ((R >> 4) & 3)) : R;
        voffA[i] = (unsigned)(Ra * lda + C) * 2u; voffB[i] = (unsigned)(Rb * K + C) * 2u; }
    const size_t kstep = (size_t)(BK * 2);
    const size_t hstepA = (size_t)HALF * lda * 2, hstepB = (size_t)HALF * K * 2;
    const size_t tstepA = 2 * hstepA, tstepB = 2 * hstepB;
    const unsigned ldsw = (unsigned)wid * 1024u;
    const int aoff = lds_byte(wr * 64 + fr, fq * 8), boff = lds_byte(wc * 32 + fr, fq * 8);
#define PG8_SA(b, h) (((b) * 2 + (h)) * HTB)
#define PG8_SB(b, h) ((4 + (b) * 2 + (h)) * HTB)
#define PG8_STAGE(bufoff, gbase, voff) do { _Pragma("unroll") for (int _i = 0; _i < 2; ++_i) \
        __builtin_amdgcn_global_load_lds((const unsigned*)((const char*)(gbase) + (voff)[_i]), (LAS unsigned*)(lds + (bufoff) + ldsw + _i * 8192), 16, 0, 0); } while (0)
#define PG8_LDA(dst, b, h) do { _Pragma("unroll") for (int m = 0; m < 4; ++m) _Pragma("unroll") for (int k = 0; k < 2; ++k) dst[m][k] = *(const LAS bf16x8*)(lds + PG8_SA(b, h) + aoff + m * 2048 + k * 1024); } while (0)
#define PG8_LDB(dst, b, h) do { _Pragma("unroll") for (int n = 0; n < 2; ++n) _Pragma("unroll") for (int k = 0; k < 2; ++k) dst[n][k] = *(const LAS bf16x8*)(lds + PG8_SB(b, h) + boff + n * 2048 + k * 1024); } while (0)
#define PG8_MMA(ai, bj, At, Bt) do { __builtin_amdgcn_s_setprio(1); _Pragma("unroll") for (int m = 0; m < 4; ++m) _Pragma("unroll") for (int n = 0; n < 2; ++n) _Pragma("unroll") for (int k = 0; k < 2; ++k) \
        acc[ai][bj][m][n] = __builtin_amdgcn_mfma_f32_16x16x32_bf16(Bt[n][k], At[m][k], acc[ai][bj][m][n], 0, 0, 0); __builtin_amdgcn_s_setprio(0); } while (0)
#define PG8_WAIT_V(n) asm volatile("s_waitcnt vmcnt(" #n ")" ::: "memory")
#define PG8_WAIT_L(n) asm volatile("s_waitcnt lgkmcnt(" #n ")" ::: "memory")
#define PG8_BAR __builtin_amdgcn_s_barrier()
#define PG8_SCHED __builtin_amdgcn_sched_barrier(0)
    Unit cur, nxt; int ui = 0;
    if (!S.next(0, cur)) return;
    f32x4 acc[2][2][4][2];
#pragma unroll
    for (int a = 0; a < 2; ++a)
#pragma unroll
        for (int b = 0; b < 2; ++b)
#pragma unroll
            for (int m = 0; m < 4; ++m)
#pragma unroll
                for (int n = 0; n < 2; ++n) acc[a][b][m][n] = (f32x4){0.f, 0.f, 0.f, 0.f};
    bf16x8 At[4][2], B0[2][2], B1[2][2];
    const char* cA = (const char*)g.A + (size_t)cur.pm * tstepA + (size_t)((cur.pn >> g.ashift) * g.astep) * 2; const char* cB = (const char*)g.Bt + (size_t)cur.pn * tstepB;
    PG8_STAGE(PG8_SB(0, 0), cB, voffB); PG8_STAGE(PG8_SB(0, 1), cB + hstepB, voffB); PG8_STAGE(PG8_SA(0, 0), cA, voffA); PG8_STAGE(PG8_SA(0, 1), cA + hstepA, voffA);
    if (wr == 1) PG8_BAR;
    PG8_WAIT_V(2); PG8_BAR;
    PG8_STAGE(PG8_SB(1, 0), cB + kstep, voffB); PG8_STAGE(PG8_SA(1, 0), cA + kstep, voffA); PG8_STAGE(PG8_SB(1, 1), cB + hstepB + kstep, voffB);
    PG8_WAIT_V(6); PG8_BAR;
    for (;;) {
        const bool has_next = S.next(ui + 1, nxt);
        const char* nA = has_next ? (const char*)g.A + (size_t)nxt.pm * tstepA + (size_t)((nxt.pn >> g.ashift) * g.astep) * 2 : cA; const char* nB = has_next ? (const char*)g.Bt + (size_t)nxt.pn * tstepB : cB;
        for (int t = 0; t < nt; t += 2) {
            const bool last = (t == nt - 2);
            const char* a1 = cA + (size_t)(t + 1) * kstep;
            const char* a2 = last ? nA : cA + (size_t)(t + 2) * kstep; const char* b2 = last ? nB : cB + (size_t)(t + 2) * kstep;
            const char* a3 = a2 + kstep; const char* b3 = b2 + kstep;
            PG8_LDB(B0, 0, 0); PG8_LDB(B1, 0, 1); PG8_SCHED; PG8_LDA(At, 0, 0); PG8_STAGE(PG8_SA(1, 1), a1 + hstepA, voffA);
            PG8_WAIT_V(8); PG8_WAIT_L(0); PG8_BAR; PG8_MMA(0, 0, At, B0); PG8_MMA(0, 1, At, B1); PG8_BAR; PG8_SCHED;
            PG8_LDA(At, 0, 1); PG8_STAGE(PG8_SB(0, 0), b2, voffB); PG8_STAGE(PG8_SB(0, 1), b2 + hstepB, voffB); PG8_STAGE(PG8_SA(0, 0), a2, voffA);
            PG8_WAIT_V(8); PG8_WAIT_L(0); PG8_BAR; PG8_MMA(1, 0, At, B0); PG8_MMA(1, 1, At, B1); PG8_BAR; PG8_SCHED;
            PG8_LDB(B0, 1, 0); PG8_LDB(B1, 1, 1); PG8_SCHED; PG8_LDA(At, 1, 0); PG8_STAGE(PG8_SA(0, 1), a2 + hstepA, voffA);
            PG8_WAIT_V(8); PG8_WAIT_L(0); PG8_BAR; PG8_MMA(0, 0, At, B0); PG8_MMA(0, 1, At, B1); PG8_BAR; PG8_SCHED;
            PG8_LDA(At, 1, 1); PG8_STAGE(PG8_SB(1, 0), b3, voffB); PG8_STAGE(PG8_SB(1, 1), b3 + hstepB, voffB); PG8_STAGE(PG8_SA(1, 0), a3, voffA);
            PG8_WAIT_V(8); PG8_WAIT_L(0); PG8_BAR; PG8_MMA(1, 0, At, B0); PG8_MMA(1, 1, At, B1); PG8_BAR; PG8_SCHED;
        }
        if (wr == 0) PG8_BAR;
        if constexpr (Epi::ROWPERM) E(acc, cur, wr, wc, 0, 0, has_next ? nxt.pn : -1); else E(acc, cur, wr, wc, 0, 0);
        if (!has_next) break;
#pragma unroll
        for (int a = 0; a < 2; ++a)
#pragma unroll
            for (int b = 0; b < 2; ++b)
#pragma unroll
                for (int m = 0; m < 4; ++m)
#pragma unroll
                    for (int n = 0; n < 2; ++n) acc[a][b][m][n] = (f32x4){0.f, 0.f, 0.f, 0.f};
        cur = nxt; cA = nA; cB = nB; ++ui;
        if (wr == 1) PG8_BAR;
    }
    PG8_WAIT_V(0);
    PG8_BAR;
#undef PG8_SA
#undef PG8_SB
#undef PG8_STAGE
#undef PG8_LDA
#undef PG8_LDB
#undef PG8_MMA
#undef PG8_WAIT_V
#undef PG8_WAIT_L
#undef PG8_BAR
#undef PG8_SCHED
}


struct EpiZ {
    static constexpr bool PERM = true, ROWPERM = false;
    bf16_t* O; int ldc; const float* bias; int split_cols; size_t split_stride; const float* ss; int act_pn; float* ssv; int ssv_pn0; LAS float* R;
    int post; const bf16_t* pin; bf16_t* pout; const float* pw; const float* pb;
    __device__ __forceinline__ void operator()(const f32x4 (&acc)[2][2][4][2], const Unit& u, int wr, int wc, int fr, int fq) const {
        { const int l_ = lane_id_hw(); fr = l_ & 15; fq = l_ >> 4; }
        if (ss) { if (*(volatile LAS int*)(R + 256) != u.pm) {
            const int wv = 4 * wr + wc; if (wv < 4) { const int r = wv * 64 + fq * 16 + fr; R[r] = rsqrtf(sum16(ss + (size_t)(u.pm * BM + r) * 16) * (1.0f / 1024.0f) + EPS); }
            asm volatile("s_waitcnt lgkmcnt(0)" ::: "memory"); __builtin_amdgcn_s_barrier(); asm volatile("" ::: "memory");
            if (wv == 0 && fq == 0 && fr == 0) *(volatile LAS int*)(R + 256) = u.pm; } }
        const int row0 = u.pm * BM + wr * 64 + fr; int colt = u.pn * BM; bf16_t* base = O;
        if (split_cols) { const int t = colt / split_cols; base += (size_t)t * split_stride; colt -= t * split_cols; }
        const int col0 = colt + wc * 32 + 8 * fq, bcol0 = u.pn * BM + wc * 32 + 8 * fq;
        const bool act = (u.pn < act_pn);
        const bool dss = (ssv != nullptr) && (u.pn >= ssv_pn0);
        f32x4 bv[2][2];
#pragma unroll
        for (int bj = 0; bj < 2; ++bj)
#pragma unroll
            for (int n = 0; n < 2; ++n) bv[bj][n] = bias ? *(const f32x4*)(bias + bcol0 + bj * HALF + 4 * n) : (f32x4){0.f, 0.f, 0.f, 0.f};
#pragma unroll
        for (int ai = 0; ai < 2; ++ai)
#pragma unroll
            for (int m = 0; m < 4; ++m) {
                const int row = row0 + ai * HALF + m * 16;
                float rs = 1.0f; if (ss) rs = R[wr * 64 + fr + ai * HALF + m * 16];
                bf16_t* rowp = base + (size_t)row * ldc + col0; float sq = 0.f;
#pragma unroll
                for (int bj = 0; bj < 2; ++bj) { f32x4 v0 = acc[ai][bj][m][0] * rs + bv[bj][0], v1 = acc[ai][bj][m][1] * rs + bv[bj][1];
                    if (act) { const f32x2v a = gelu_tanh_pk((f32x2v){v0[0], v0[1]}), b = gelu_tanh_pk((f32x2v){v0[2], v0[3]}), c = gelu_tanh_pk((f32x2v){v1[0], v1[1]}), d = gelu_tanh_pk((f32x2v){v1[2], v1[3]});
                        v0 = (f32x4){a.x, a.y, b.x, b.y}; v1 = (f32x4){c.x, c.y, d.x, d.y}; }
                    sq += (v0[0] * v0[0] + v0[1] * v0[1]) + (v0[2] * v0[2] + v0[3] * v0[3]) + (v1[0] * v1[0] + v1[1] * v1[1]) + (v1[2] * v1[2] + v1[3] * v1[3]);
                    u32x4 w; w.x = cvt_pk_bf16(v0[0], v0[1]); w.y = cvt_pk_bf16(v0[2], v0[3]); w.z = cvt_pk_bf16(v1[0], v1[1]); w.w = cvt_pk_bf16(v1[2], v1[3]);
                    *(u32x4*)(rowp + bj * HALF) = w; }
                if (dss) { sq += __shfl_xor(sq, 16); sq += __shfl_xor(sq, 32); if (fq == 0) ssv[(size_t)row * 32 + (u.pn - ssv_pn0) * 4 + wc] = sq; }
                asm volatile("" ::: "memory");
            }
        if (post != 0 && u.pn >= (post == 1 ? 8 : post == 2 ? 4 : 0)) {
            asm volatile("s_waitcnt vmcnt(0)" ::: "memory"); __builtin_amdgcn_s_barrier(); asm volatile("" ::: "memory");
            const int t = (4 * wr + wc) * 64 + fq * 16 + fr, cb0 = (u.pn - (post == 1 ? 8 : post == 2 ? 4 : 0)) * 256;
            const int c = cb0 + (t & 31) * 8, rb = t >> 5, rowb = u.pm * BM + rb * 16;
            if (post == 3) {
                const bf16_t* zb = pin + (size_t)rowb * D + c; bf16_t* yb = pout + (size_t)rowb * D + c;
                if (u.pn == 0) pool_post<2>(zb, yb, rb); else if (u.pn == 1) pool_post<4>(zb, yb, rb); else if (u.pn == 2) pool_post<8>(zb, yb, rb); else pool_post<16>(zb, yb, rb);
            } else if (post == 1) {
                const bf16_t* zb = pin + (size_t)rowb * 3072 + c; bf16_t* yb = pout + (size_t)rowb * D + c;
                f32x4 w[3][2];
#pragma unroll
                for (int k = 0; k < 3; ++k) { w[k][0] = *(const f32x4*)(pw + k * 1024 + c); w[k][1] = *(const f32x4*)(pw + k * 1024 + c + 4); }
                float p2[8], p1[8];
#pragma unroll
                for (int j = 0; j < 8; ++j) { p2[j] = 0.f; p1[j] = 0.f; }
                if (rb > 0) { float a_[8], b_[8]; unpack8(*(const u32x4*)(zb - 2 * 3072 + 1024), a_); unpack8(*(const u32x4*)(zb - 2 * 3072 + 2048), b_);
#pragma unroll
                    for (int j = 0; j < 8; ++j) p2[j] = a_[j] * b_[j];
                    unpack8(*(const u32x4*)(zb - 3072 + 1024), a_); unpack8(*(const u32x4*)(zb - 3072 + 2048), b_);
#pragma unroll
                    for (int j = 0; j < 8; ++j) p1[j] = a_[j] * b_[j]; }
#pragma unroll
                for (int hf = 0; hf < 2; ++hf) {
                    u32x4 cv[8], xv[8], bv[8];
#pragma unroll
                    for (int i = 0; i < 8; ++i) { const bf16_t* zr = zb + (size_t)(hf * 8 + i) * 3072; bv[i] = *(const u32x4*)zr; cv[i] = *(const u32x4*)(zr + 1024); xv[i] = *(const u32x4*)(zr + 2048); }
#pragma unroll
                    for (int i = 0; i < 8; ++i) { float cf[8], xf[8], bf[8], o[8]; unpack8(cv[i], cf); unpack8(xv[i], xf); unpack8(bv[i], bf);
#pragma unroll
                        for (int j = 0; j < 8; ++j) { const float pr = cf[j] * xf[j]; o[j] = bf[j] * (w[0][j >> 2][j & 3] * p2[j] + (w[1][j >> 2][j & 3] * p1[j] + w[2][j >> 2][j & 3] * pr)); p2[j] = p1[j]; p1[j] = pr; }
                        *(u32x4*)(yb + (size_t)(hf * 8 + i) * D) = pack8(o); }
                }
            } else {
                const bf16_t* zb = pin + (size_t)rowb * D + c; bf16_t* yb = pout + (size_t)rowb * D + c;
                f32x4 w[4][2], bb[2];
#pragma unroll
                for (int k = 0; k < 4; ++k) { w[k][0] = *(const f32x4*)(pw + k * 1024 + c); w[k][1] = *(const f32x4*)(pw + k * 1024 + c + 4); }
                bb[0] = *(const f32x4*)(pb + c); bb[1] = *(const f32x4*)(pb + c + 4);
                float q3[8], q2[8], q1[8];
#pragma unroll
                for (int j = 0; j < 8; ++j) { q3[j] = 0.f; q2[j] = 0.f; q1[j] = 0.f; }
                if (rb > 0) { unpack8(*(const u32x4*)(zb - 3 * D), q3); unpack8(*(const u32x4*)(zb - 2 * D), q2); unpack8(*(const u32x4*)(zb - D), q1); }
#pragma unroll
                for (int hf = 0; hf < 2; ++hf) {
                    u32x4 zv[8];
#pragma unroll
                    for (int i = 0; i < 8; ++i) zv[i] = *(const u32x4*)(zb + (size_t)(hf * 8 + i) * D);
#pragma unroll
                    for (int i = 0; i < 8; ++i) { float zf[8], o[8]; unpack8(zv[i], zf);
#pragma unroll
                        for (int j = 0; j < 8; ++j) { o[j] = bb[j >> 2][j & 3] + w[0][j >> 2][j & 3] * q3[j] + (w[1][j >> 2][j & 3] * q2[j] + (w[2][j >> 2][j & 3] * q1[j] + w[3][j >> 2][j & 3] * zf[j])); q3[j] = q2[j]; q2[j] = q1[j]; q1[j] = zf[j]; }
                        *(u32x4*)(yb + (size_t)(hf * 8 + i) * D) = pack8(o); }
                }
            }
        }
    }
};

struct EpiRes {
    static constexpr bool PERM = true, ROWPERM = false;
    bf16_t* xb; float* ssn;
    __device__ __forceinline__ void operator()(const f32x4 (&acc)[2][2][4][2], const Unit& u, int wr, int wc, int fr, int fq) const {
        { const int l_ = lane_id_hw(); fr = l_ & 15; fq = l_ >> 4; }
        const int row0 = u.pm * BM + wr * 64 + fr, col0 = u.pn * BM + wc * 32 + 8 * fq;
        u32x4 xo[2][4][2];
#pragma unroll
        for (int ai = 0; ai < 2; ++ai)
#pragma unroll
            for (int m = 0; m < 4; ++m) { const size_t off = (size_t)(row0 + ai * HALF + m * 16) * D + col0;
#pragma unroll
                for (int bj = 0; bj < 2; ++bj) xo[ai][m][bj] = *(const u32x4*)(xb + off + bj * HALF); }
#pragma unroll
        for (int ai = 0; ai < 2; ++ai) {
#pragma unroll
            for (int m = 0; m < 4; ++m) { const int row = row0 + ai * HALF + m * 16; const size_t off = (size_t)row * D + col0; float sq = 0.f;
#pragma unroll
                for (int bj = 0; bj < 2; ++bj) {
                    float xf[8]; unpack8(xo[ai][m][bj], xf);
                    const f32x4 x0 = (f32x4){xf[0], xf[1], xf[2], xf[3]} + acc[ai][bj][m][0], x1 = (f32x4){xf[4], xf[5], xf[6], xf[7]} + acc[ai][bj][m][1];
                    sq += (x0[0] * x0[0] + x0[1] * x0[1]) + (x0[2] * x0[2] + x0[3] * x0[3]) + (x1[0] * x1[0] + x1[1] * x1[1]) + (x1[2] * x1[2] + x1[3] * x1[3]);
                    u32x4 w; w.x = cvt_pk_bf16(x0[0], x0[1]); w.y = cvt_pk_bf16(x0[2], x0[3]); w.z = cvt_pk_bf16(x1[0], x1[1]); w.w = cvt_pk_bf16(x1[2], x1[3]);
                    *(u32x4*)(xb + off + bj * HALF) = w; }
                sq += __shfl_xor(sq, 16); sq += __shfl_xor(sq, 32); if (fq == 0) ssn[(size_t)row * 16 + u.pn * 4 + wc] = sq; }
            asm volatile("" ::: "memory");
        }
    }
};

struct EpiResFinal {
    static constexpr bool PERM = true, ROWPERM = false;
    const bf16_t* xb; float* ssn; unsigned* cnt; float* out; const float* g; LAS float* R;
    __device__ __forceinline__ void operator()(f32x4 (&acc)[2][2][4][2], const Unit& u, int wr, int wc, int fr, int fq) const {
        { const int l_ = lane_id_hw(); fr = l_ & 15; fq = l_ >> 4; }
        const int row0 = u.pm * BM + wr * 64 + fr, col0 = u.pn * BM + wc * 32 + 8 * fq, wv = 4 * wr + wc;
        u32x4 xo[2][4][2];
#pragma unroll
        for (int ai = 0; ai < 2; ++ai)
#pragma unroll
            for (int m = 0; m < 4; ++m) { const size_t off = (size_t)(row0 + ai * HALF + m * 16) * D + col0;
#pragma unroll
                for (int bj = 0; bj < 2; ++bj) xo[ai][m][bj] = *(const u32x4*)(xb + off + bj * HALF); }
#pragma unroll
        for (int ai = 0; ai < 2; ++ai)
#pragma unroll
            for (int m = 0; m < 4; ++m) { const int row = row0 + ai * HALF + m * 16; float sq = 0.f;
#pragma unroll
                for (int bj = 0; bj < 2; ++bj) {
                    float xf[8]; unpack8(xo[ai][m][bj], xf);
                    const f32x4 x0 = (f32x4){xf[0], xf[1], xf[2], xf[3]} + acc[ai][bj][m][0], x1 = (f32x4){xf[4], xf[5], xf[6], xf[7]} + acc[ai][bj][m][1];
                    sq += (x0[0] * x0[0] + x0[1] * x0[1]) + (x0[2] * x0[2] + x0[3] * x0[3]) + (x1[0] * x1[0] + x1[1] * x1[1]) + (x1[2] * x1[2] + x1[3] * x1[3]);
                    acc[ai][bj][m][0] = x0; acc[ai][bj][m][1] = x1; }
                sq += __shfl_xor(sq, 16); sq += __shfl_xor(sq, 32);
                if (fq == 0) __hip_atomic_store(ssn + (size_t)row * 16 + u.pn * 4 + wc, sq, __ATOMIC_RELAXED, __HIP_MEMORY_SCOPE_AGENT); }
        asm volatile("s_waitcnt vmcnt(0)" ::: "memory"); __builtin_amdgcn_s_barrier(); asm volatile("" ::: "memory");
        if (wv == 0) {
            if (fq == 0 && fr == 0) __hip_atomic_fetch_add(cnt + u.pm, 1u, __ATOMIC_RELAXED, __HIP_MEMORY_SCOPE_AGENT);
            unsigned sp = 0;
            while ((unsigned)__builtin_amdgcn_readfirstlane((int)__hip_atomic_load(cnt + u.pm, __ATOMIC_RELAXED, __HIP_MEMORY_SCOPE_AGENT)) < 4u) { __builtin_amdgcn_s_sleep(1); if (++sp > (1u << 20)) break; }
            __builtin_amdgcn_fence(__ATOMIC_ACQUIRE, "agent");
            asm volatile("s_waitcnt vmcnt(0)" ::: "memory");
        }
        __builtin_amdgcn_s_barrier(); asm volatile("" ::: "memory");
        if (wv < 4) { const int r = wv * 64 + fq * 16 + fr; const float* pp = ssn + (size_t)(u.pm * BM + r) * 16; float q = 0.f;
#pragma unroll
            for (int k = 0; k < 16; ++k) q += __hip_atomic_load(pp + k, __ATOMIC_RELAXED, __HIP_MEMORY_SCOPE_AGENT);
            R[r] = rsqrtf(q * (1.0f / 1024.0f) + EPS); }
        asm volatile("s_waitcnt lgkmcnt(0)" ::: "memory"); __builtin_amdgcn_s_barrier(); asm volatile("" ::: "memory");
        *(volatile LAS int*)(R + 256) = -1;
        f32x4 gv[2][2];
#pragma unroll
        for (int bj = 0; bj < 2; ++bj) { gv[bj][0] = *(const f32x4*)(g + col0 + bj * HALF); gv[bj][1] = *(const f32x4*)(g + col0 + bj * HALF + 4); }
#pragma unroll
        for (int ai = 0; ai < 2; ++ai)
#pragma unroll
            for (int m = 0; m < 4; ++m) { const int rl = wr * 64 + fr + ai * HALF + m * 16; const float rs = R[rl]; float* op = out + (size_t)(u.pm * BM + rl) * D + col0;
#pragma unroll
                for (int bj = 0; bj < 2; ++bj) { *(f32x4*)(op + bj * HALF) = acc[ai][bj][m][0] * rs * gv[bj][0]; *(f32x4*)(op + bj * HALF + 4) = acc[ai][bj][m][1] * rs * gv[bj][1]; } }
    }
};

__device__ __forceinline__ float softplus_neg(float l) { const float e = __expf(-l); return (e < 0.03f) ? e * (1.0f - e * (0.5f - e * (0.33333333f - 0.25f * e))) : __logf(1.0f + e); }
__device__ __forceinline__ float one_minus_exp(float x) { return 1.0f - __expf(x); }
struct EpiGate {
    static constexpr bool PERM = true, ROWPERM = false;
    const bf16_t* xrc; const float* b_a; const float* b_i; const float* lam; unsigned* AB; float* Ls; float* Hs;
    __device__ __forceinline__ void operator()(const f32x4 (&acc)[2][2][4][2], const Unit& u, int wr, int wc, int fr, int fq) const {
        { const int l_ = lane_id_hw(); fr = l_ & 15; fq = l_ >> 4; }
        const int row0 = u.pm * BM + wr * 64 + fr, c0 = (u.pn >> 1) * 256 + (u.pn & 1) * 128 + wc * 32 + 8 * fq;
#pragma unroll
        for (int hf = 0; hf < 2; ++hf) {
            const f32x4 lv = *(const f32x4*)(lam + c0 + 4 * hf), bav = *(const f32x4*)(b_a + c0 + 4 * hf), biv = *(const f32x4*)(b_i + c0 + 4 * hf);
            f32x4 sp;
#pragma unroll
            for (int j = 0; j < 4; ++j) sp[j] = 8.0f * softplus_neg(lv[j]);
#pragma unroll
            for (int ai = 0; ai < 2; ++ai)
#pragma unroll
                for (int m = 0; m < 4; ++m) {
                    const int row = row0 + ai * HALF + m * 16; const size_t off = (size_t)row * D + c0 + 4 * hf;
                    const u32x2 xw = *(const u32x2*)(xrc + off); const float xr[4] = {bf_lo(xw.x), bf_hi(xw.x), bf_lo(xw.y), bf_hi(xw.y)};
                    u32x4 w;
#pragma unroll
                    for (int j2 = 0; j2 < 2; ++j2) { const int j = 2 * j2;
                        const f32x2v rp = (f32x2v){acc[ai][0][m][hf][j], acc[ai][0][m][hf][j + 1]} + (f32x2v){bav[j], bav[j + 1]}, ip = (f32x2v){acc[ai][1][m][hf][j], acc[ai][1][m][hf][j + 1]} + (f32x2v){biv[j], biv[j + 1]};
                        const f32x2v er = rp * (-1.4426950408889634f), ei = ip * (-1.4426950408889634f);
                        f32x2v tr, ti; tr.x = __builtin_amdgcn_exp2f(er.x); tr.y = __builtin_amdgcn_exp2f(er.y); ti.x = __builtin_amdgcn_exp2f(ei.x); ti.y = __builtin_amdgcn_exp2f(ei.y);
                        const f32x2v dr = tr + 1.0f, di = ti + 1.0f; f32x2v r, ig; r.x = __builtin_amdgcn_rcpf(dr.x); r.y = __builtin_amdgcn_rcpf(dr.y); ig.x = __builtin_amdgcn_rcpf(di.x); ig.y = __builtin_amdgcn_rcpf(di.y);
                        const f32x2v la = r * (f32x2v){-sp[j], -sp[j + 1]}, e2 = la * 2.8853900817779268f;
                        f32x2v a2; a2.x = __builtin_amdgcn_exp2f(e2.x); a2.y = __builtin_amdgcn_exp2f(e2.y);
                        const f32x2v om = __builtin_elementwise_max(1.0f - a2, (f32x2v){0.f, 0.f}); f32x2v mult; mult.x = __builtin_amdgcn_sqrtf(om.x); mult.y = __builtin_amdgcn_sqrtf(om.y);
                        const f32x2v bt = (mult * ig) * (f32x2v){xr[j], xr[j + 1]};
                        w[j] = pack_f16(la.x, bt.x); w[j + 1] = pack_f16(la.y, bt.y); }
                    *(u32x4*)(AB + off) = w;
                    asm volatile("" ::: "memory");
                }
        }
        asm volatile("s_waitcnt vmcnt(0)" ::: "memory"); __builtin_amdgcn_s_barrier(); asm volatile("" ::: "memory");
        { const int t = (4 * wr + wc) * 64 + fq * 16 + fr, chunk = t >> 7, c = (u.pn >> 1) * 256 + (u.pn & 1) * 128 + (t & 127), r0 = u.pm * BM + chunk * 64;
          const unsigned* ab = AB + (size_t)r0 * D + c; float h = 0.f, L = 0.f;
#pragma unroll
          for (int b4 = 0; b4 < 4; ++b4) { unsigned w[16];
#pragma unroll
              for (int i = 0; i < 16; ++i) w[i] = ab[(size_t)(b4 * 16 + i) * D];
#pragma unroll
              for (int i = 0; i < 16; ++i) { const float la = f16_lo(w[i]); h = __expf(la) * h + f16_hi(w[i]); L += la; } }
          const size_t o = (size_t)(r0 >> 6) * 1024 + c; Ls[o] = L; Hs[o] = h; }
    }
};

__device__ __forceinline__ float dpp_ror1(float v) { return __builtin_bit_cast(float, __builtin_amdgcn_mov_dpp(__builtin_bit_cast(int, v), 0x121, 0xf, 0xf, false)); }
__device__ __forceinline__ float dpp_ror2(float v) { return __builtin_bit_cast(float, __builtin_amdgcn_mov_dpp(__builtin_bit_cast(int, v), 0x122, 0xf, 0xf, false)); }
__device__ __forceinline__ float dpp_shr1(float old, float v) { return __builtin_bit_cast(float, __builtin_amdgcn_update_dpp(__builtin_bit_cast(int, old), __builtin_bit_cast(int, v), 0x111, 0xf, 0xf, false)); }
__device__ __forceinline__ float dpp_shr2(float old, float v) { return __builtin_bit_cast(float, __builtin_amdgcn_update_dpp(__builtin_bit_cast(int, old), __builtin_bit_cast(int, v), 0x112, 0xf, 0xf, false)); }
struct EpiFfn {
    static constexpr bool PERM = true, ROWPERM = true;
    bf16_t* A2; const float* ss; const float* cw; const float* cb; float* ZS; LAS float* H;
    __device__ __forceinline__ void operator()(f32x4 (&acc)[2][2][4][2], const Unit& u, int wr, int wc, int fr, int fq, int next_pn) const {
        { const int l_ = lane_id_hw(); fr = l_ & 15; fq = l_ >> 4; }
        const int rl0 = wr * 64 + 4 * fr, tcol = wc * 32 + 8 * fq, c0 = u.pn * 128 + tcol;
        LAS float* R = H + 3 * 2 * 256; LAS float* WL0 = R + 256 + 64; volatile LAS int* wtag = (volatile LAS int*)(R + 256 + 16);
        const int t2 = ((4 * wr + wc) * 64 + fq * 16 + fr) * 2, wk = t2 >> 8, wtc = t2 & 255, wl_idx = t2;
        const int tag0 = wtag[0], tag1 = wtag[1];
        const int bcur = (tag1 == u.pn) ? 1 : 0; const bool have = (tag0 == u.pn) || (tag1 == u.pn);
        LAS float* WL = WL0 + bcur * 1024;
        f32x2v wl2 = {0.f, 0.f}, wn2 = {0.f, 0.f};
        if (!have) { const float* src = (wk < 3 ? cw + wk * 5632 : cb) + (wtc >> 7) * FFW + u.pn * 128 + (wtc & 127); wl2 = *(const f32x2v*)src; }
        if (next_pn >= 0) { const float* src = (wk < 3 ? cw + wk * 5632 : cb) + (wtc >> 7) * FFW + next_pn * 128 + (wtc & 127); wn2 = *(const f32x2v*)src; }
        if (*(volatile LAS int*)(R + 256) != u.pm) {
            const int wv = 4 * wr + wc, l_ = lane_id_hw(); if (wv < 4) { const int r = wv * 64 + l_; R[r] = rsqrtf(sum16(ss + (size_t)(u.pm * BM + r) * 16) * (1.0f / 1024.0f) + EPS); }
            asm volatile("s_waitcnt lgkmcnt(0)" ::: "memory"); __builtin_amdgcn_s_barrier(); asm volatile("" ::: "memory");
            if (wv == 0 && l_ == 0) *(volatile LAS int*)(R + 256) = u.pm; }
#pragma unroll
        for (int ai = 0; ai < 2; ++ai) { const f32x4 rs4 = *(const LAS f32x4*)(R + rl0 + ai * HALF);
#pragma unroll
            for (int m = 0; m < 4; ++m)
#pragma unroll
                for (int bj = 0; bj < 2; ++bj) { acc[ai][bj][m][0] *= rs4[m]; acc[ai][bj][m][1] *= rs4[m]; } }
#pragma unroll
        for (int ai = 0; ai < 2; ++ai) { const int sl = 2 * ai + wr;
            if (fr == 15) {
#pragma unroll
                for (int k = 0; k < 2; ++k)
#pragma unroll
                    for (int bj = 0; bj < 2; ++bj)
#pragma unroll
                        for (int n = 0; n < 2; ++n) {
                            if (sl < 3) *(LAS f32x4*)(H + (sl * 2 + k) * 256 + bj * 128 + tcol + 4 * n) = acc[ai][bj][2 + k][n];
                            else *(f32x4*)(ZS + ((size_t)u.pm * 4 + 2 + k) * 5632 + bj * FFW + c0 + 4 * n) = acc[ai][bj][2 + k][n]; } }
            if (sl == 0 && fr == 0) {
#pragma unroll
                for (int k = 0; k < 2; ++k)
#pragma unroll
                    for (int bj = 0; bj < 2; ++bj)
#pragma unroll
                        for (int n = 0; n < 2; ++n) *(f32x4*)(ZS + ((size_t)u.pm * 4 + k) * 5632 + bj * FFW + c0 + 4 * n) = acc[ai][bj][k][n]; } }
        if (!have) *(LAS f32x2v*)(WL + wl_idx) = wl2;
        asm volatile("s_waitcnt lgkmcnt(0)" ::: "memory"); __builtin_amdgcn_s_barrier(); asm volatile("" ::: "memory"); __builtin_amdgcn_sched_barrier(0);
        int rowb = u.pm * BM + rl0; asm volatile("" : "+v"(rowb));
#pragma unroll
        for (int hf = 0; hf < 2; ++hf) {
            __builtin_amdgcn_sched_barrier(0);
            const int c = c0 + 4 * hf;
            const LAS float* wl = WL + tcol + 4 * hf;
            const f32x4 wg0 = *(const LAS f32x4*)(wl), wg1 = *(const LAS f32x4*)(wl + 256), wg2 = *(const LAS f32x4*)(wl + 512), bg = *(const LAS f32x4*)(wl + 768);
            const f32x4 wv0 = *(const LAS f32x4*)(wl + 128), wv1 = *(const LAS f32x4*)(wl + 384), wv2 = *(const LAS f32x4*)(wl + 640), bvv = *(const LAS f32x4*)(wl + 896);
#pragma unroll
            for (int ai = 0; ai < 2; ++ai) { const int sl = 2 * ai + wr;
                f32x4 hg62 = (f32x4){0.f, 0.f, 0.f, 0.f}, hg63 = hg62, hv62 = hg62, hv63 = hg62;
                if (sl > 0) { const LAS float* hp = H + ((sl - 1) * 2) * 256 + tcol + 4 * hf; hg62 = *(const LAS f32x4*)hp; hv62 = *(const LAS f32x4*)(hp + 128); hg63 = *(const LAS f32x4*)(hp + 256); hv63 = *(const LAS f32x4*)(hp + 384); }
                f32x4 sg3, sg2, sv3, sv2;
#pragma unroll
                for (int j = 0; j < 4; ++j) { sg3[j] = dpp_shr1(hg63[j], acc[ai][0][3][hf][j]); sg2[j] = dpp_shr1(hg62[j], acc[ai][0][2][hf][j]); sv3[j] = dpp_shr1(hv63[j], acc[ai][1][3][hf][j]); sv2[j] = dpp_shr1(hv62[j], acc[ai][1][2][hf][j]); }
#pragma unroll
                for (int m = 0; m < 4; ++m) {
                    const f32x4 cg = acc[ai][0][m][hf], cv = acc[ai][1][m][hf];
                    const f32x4 g1v = (m == 0) ? sg3 : acc[ai][0][m == 0 ? 0 : m - 1][hf], g2v = (m == 0) ? sg2 : (m == 1) ? sg3 : acc[ai][0][m < 2 ? 0 : m - 2][hf];
                    const f32x4 v1v = (m == 0) ? sv3 : acc[ai][1][m == 0 ? 0 : m - 1][hf], v2v = (m == 0) ? sv2 : (m == 1) ? sv3 : acc[ai][1][m < 2 ? 0 : m - 2][hf];
                    float o[4];
#pragma unroll
                    for (int j2 = 0; j2 < 2; ++j2) {
                        const int j = 2 * j2;
                        const f32x2v g1 = {g1v[j], g1v[j + 1]}, g2 = {g2v[j], g2v[j + 1]}, v1 = {v1v[j], v1v[j + 1]}, v2 = {v2v[j], v2v[j + 1]};
                        const f32x2v c_g = {cg[j], cg[j + 1]}, c_v = {cv[j], cv[j + 1]};
                        const f32x2v gc = (f32x2v){wg0[j], wg0[j + 1]} * g2 + ((f32x2v){wg1[j], wg1[j + 1]} * g1 + ((f32x2v){wg2[j], wg2[j + 1]} * c_g + (f32x2v){bg[j], bg[j + 1]}));
                        const f32x2v vc = (f32x2v){wv0[j], wv0[j + 1]} * v2 + ((f32x2v){wv1[j], wv1[j + 1]} * v1 + ((f32x2v){wv2[j], wv2[j + 1]} * c_v + (f32x2v){bvv[j], bvv[j + 1]}));
                        const f32x2v e = gc * (-1.4426950408889634f); f32x2v t; t.x = __builtin_amdgcn_exp2f(e.x); t.y = __builtin_amdgcn_exp2f(e.y);
                        const f32x2v d = t + 1.0f; f32x2v r; r.x = __builtin_amdgcn_rcpf(d.x); r.y = __builtin_amdgcn_rcpf(d.y);
                        const f32x2v oo = (gc * r) * vc; o[j] = oo.x; o[j + 1] = oo.y; }
                    u32x2 w; w.x = cvt_pk_bf16(o[0], o[1]); w.y = cvt_pk_bf16(o[2], o[3]);
                    *(u32x2*)(A2 + (size_t)(rowb + ai * HALF + m) * FFW + c) = w; }
                __builtin_amdgcn_sched_barrier(0); }
        }
        if (next_pn >= 0) { *(LAS f32x2v*)(WL0 + (1 - bcur) * 1024 + wl_idx) = wn2; }
        if (4 * wr + wc == 0 && fq == 0 && fr == 0) { wtag[bcur] = u.pn; wtag[1 - bcur] = next_pn; }
    }
};
}

struct TrJob { const float* W; const float* gain; bf16_t* dst; int ldw, sc0, nblk, K, drb, inter, r; bool found; };
__device__ __forceinline__ TrJob tr_select(const Params& p, bf16_t* WB, int it) {
    int r = it; bool found = false;
    int wi = 0, ldw = 0, sc0 = 0, nblk = 1, K = 64, drb = 0, inter = 0, gi = -1, goff = 0; size_t woff = 0, doff = 0;
#define JOB(wi_, woff_, ldw_, sc0_, ncols_, K_, doff_, drb_, inter_, gi_, goff_) if (!found) { const int ni = ((K_) / 64) * ((ncols_) / 32); if (r < ni) { wi = (wi_); woff = (size_t)(woff_); ldw = (ldw_); sc0 = (sc0_); nblk = (ncols_) / 32; K = (K_); doff = (size_t)(doff_); drb = (drb_); inter = (inter_); gi = (gi_); goff = (goff_); found = true; } else r -= ni; }
    JOB(2, 0, 4096, 0, 4096, 1024, O_A_IN, 0, 0, 1, 0)
    JOB(7, 0, 1024, 0, 1024, 2048, O_A_OUT, 0, 0, -1, 0)
    JOB(9, 0, 1024, 0, 1024, 1024, O_B_IN, 0, 0, 8, 0)
    for (int g = 0; g < 4; ++g) JOB(10, g * 65536, 256, 0, 256, 256, O_B_GRP + g * 65536, 0, 0, -1, 0)
    JOB(13, 0, 1024, 0, 1024, 1024, O_B_OUT, 0, 0, 12, 0)
    JOB(15, 0, 2048, 0, 2048, 1024, O_C_IN, 0, 0, 14, 0)
    for (int h = 0; h < 4; ++h) { JOB(19, h * 65536, 256, 0, 256, 256, O_C_GATE, h * 512, 1, -1, 0) JOB(21, h * 65536, 256, 0, 256, 256, O_C_GATE, h * 512 + 128, 1, -1, 0) }
    JOB(24, 0, 1024, 0, 1024, 1024, O_C_OUT, 0, 0, -1, 0)
    JOB(26, 0, 3072, 0, 3072, 1024, O_D_IN, 0, 0, 25, 0)
    JOB(28, 0, 1024, 0, 1024, 1024, O_D_OUT, 0, 0, -1, 0)
    for (int l = 0; l < 4; ++l) {
        JOB(30, (size_t)l * 1024 * 5632, 5632, 0, 2816, 1024, O_F + l * (F_UP_SZ + F_DN_SZ), 0, 1, 29, l * 1024)
        JOB(30, (size_t)l * 1024 * 5632, 5632, 2816, 2816, 1024, O_F + l * (F_UP_SZ + F_DN_SZ), 128, 1, 29, l * 1024)
        JOB(33, (size_t)l * 2816 * 1024, 1024, 0, 1024, 2816, O_F + l * (F_UP_SZ + F_DN_SZ) + F_UP_SZ, 0, 0, -1, 0)
    }
#undef JOB
    TrJob j; j.W = p.in[wi] + woff; j.gain = (gi >= 0) ? p.in[gi] + goff : nullptr; j.dst = WB + doff; j.ldw = ldw; j.sc0 = sc0; j.nblk = nblk; j.K = K; j.drb = drb; j.inter = inter; j.r = r; j.found = found;
    return j;
}
__device__ __forceinline__ void tr_load(const TrJob& j, float (&wv)[32], int lane) {
    const int kb = j.r / j.nblk, nb = j.r % j.nblk, k0 = 64 * kb, c0 = 32 * nb;
    const float* src = j.W + (size_t)(k0 + (lane >> 5)) * j.ldw + j.sc0 + c0 + (lane & 31);
#pragma unroll
    for (int i = 0; i < 32; ++i) wv[i] = src[(size_t)(2 * i) * j.ldw];
}
__device__ __forceinline__ void tr_store(const TrJob& j, const float (&wv)[32], LAS float* scr, int lane) {
    const int kb = j.r / j.nblk, nb = j.r % j.nblk, k0 = 64 * kb, c0 = 32 * nb;
#pragma unroll
    for (int i = 0; i < 32; ++i) { const int kk = 2 * i + (lane >> 5); scr[kk * 33 + (lane & 31)] = wv[i]; }
    asm volatile("s_waitcnt lgkmcnt(0)" ::: "memory");
    const int c = lane & 7;
    f32x4 g0 = (f32x4){1.f, 1.f, 1.f, 1.f}, g1 = g0;
    if (j.gain) { g0 = *(const f32x4*)(j.gain + k0 + 8 * c); g1 = *(const f32x4*)(j.gain + k0 + 8 * c + 4); }
#pragma unroll
    for (int q = 0; q < 4; ++q) { const int n = (lane >> 3) + 8 * q; const LAS float* s = scr + (8 * c) * 33 + n;
        const int crel = c0 + n; const int drow = j.drb + (j.inter ? ((crel >> 7) * 256 + (crel & 127)) : crel);
        u32x4 o; o.x = cvt_pk_bf16(s[0 * 33] * g0[0], s[1 * 33] * g0[1]); o.y = cvt_pk_bf16(s[2 * 33] * g0[2], s[3 * 33] * g0[3]); o.z = cvt_pk_bf16(s[4 * 33] * g1[0], s[5 * 33] * g1[1]); o.w = cvt_pk_bf16(s[6 * 33] * g1[2], s[7 * 33] * g1[3]);
        *(u32x4*)(j.dst + (size_t)drow * j.K + k0 + 8 * c) = o; }
    asm volatile("s_waitcnt lgkmcnt(0)" ::: "memory");
}

__device__ __forceinline__ void prologue_phase(const Params& p, LAS unsigned char* lds, const int tid, const int bx) {
    const int lane = tid & 63, wave = tid >> 6;
    const int gw = bx * 8 + wave, NGW = gridDim.x * 8;
    LAS float* scr = (LAS float*)(lds + wave * 16384);
    bf16_t* WB = (bf16_t*)(p.ws + WS_W);
    constexpr int TOTAL = (int)(O_END / 2048);
    {
        int it = gw; float cur[32], nxt[32]; TrJob job, jobn;
        if (it < TOTAL) { job = tr_select(p, WB, it); tr_load(job, cur, lane); }
        while (it < TOTAL) {
            const int itn = it + NGW; const bool hn = itn < TOTAL;
            if (hn) { jobn = tr_select(p, WB, itn); tr_load(jobn, nxt, lane); }
            tr_store(job, cur, scr, lane);
            if (hn) { job = jobn;
#pragma unroll
                for (int i = 0; i < 32; ++i) cur[i] = nxt[i]; }
            it = itn;
        }
    }
    const float* x = p.in[0]; bf16_t* xb = (bf16_t*)(p.ws + WS_XB); float* SS = (float*)(p.ws + WS_SS);
    for (int rowq = gw; rowq < M / 4; rowq += NGW) {
        f32x4 v[4][4];
#pragma unroll
        for (int q = 0; q < 4; ++q) { const f32x4* xr = (const f32x4*)(x + (size_t)(rowq * 4 + q) * D) + lane;
#pragma unroll
            for (int j = 0; j < 4; ++j) v[q][j] = xr[64 * j]; }
#pragma unroll
        for (int q = 0; q < 4; ++q) { const int row = rowq * 4 + q; u32x2* o = (u32x2*)(xb + (size_t)row * D) + lane; float s = 0.f;
#pragma unroll
            for (int j = 0; j < 4; ++j) { const f32x4 vv = v[q][j]; s += (vv[0] * vv[0] + vv[1] * vv[1]) + (vv[2] * vv[2] + vv[3] * vv[3]); u32x2 w; w.x = cvt_pk_bf16(vv[0], vv[1]); w.y = cvt_pk_bf16(vv[2], vv[3]); o[64 * j] = w; }
            s = wave_sum(s); if (lane < 16) SS[(size_t)row * 16 + lane] = (lane == 0) ? s : 0.f; }
    }
}

__device__ __forceinline__ void gmlp_gate_phase(const Params& p, LAS unsigned char* lds, bf16_t* U, const bf16_t* V, const float* ssv, const int tid, const int bx) {
    const int lane = tid & 63, wave = tid >> 6, fr = lane & 15, fq = lane >> 4;
    const float* w_s = p.in[5]; const float* b_s = p.in[6]; const float* gv = p.in[4];
    LAS bf16_t* Wm = (LAS bf16_t*)lds;
    LAS bf16_t* Vs = (LAS bf16_t*)(lds + 128 * 272);
    LAS float* Rv = (LAS float*)(lds + 128 * 272 + 128 * 516);
    for (int item = bx; item < 2048; item += gridDim.x) {
        const int chunk = item >> 3, g = (item >> 1) & 3, half = item & 1;
        const int tok0 = chunk * 128, colb = g * 512 + half * 256;
        {
            const float* pp = ssv + (size_t)(tok0 + (tid >> 2)) * 32 + (tid & 3) * 8; const f32x4 a = *(const f32x4*)pp, b = *(const f32x4*)(pp + 4);
            float q = ((a[0] + a[1]) + (a[2] + a[3])) + ((b[0] + b[1]) + (b[2] + b[3])); q += __shfl_xor(q, 1); q += __shfl_xor(q, 2);
            if ((tid & 3) == 0) Rv[tid >> 2] = rsqrtf(q * (1.0f / 2048.0f) + EPS); }
        __syncthreads();
#pragma unroll
        for (int i = 0; i < 4; ++i) { const int pc = tid + 512 * i, t = pc >> 4, s0 = (pc & 15) * 8;
            const f32x4 w0 = *(const f32x4*)(w_s + ((size_t)g * 128 + t) * 128 + s0), w1 = *(const f32x4*)(w_s + ((size_t)g * 128 + t) * 128 + s0 + 4);
            float f[8];
#pragma unroll
            for (int j = 0; j < 4; ++j) { f[j] = (s0 + j <= t) ? w0[j] * Rv[s0 + j] : 0.f; f[4 + j] = (s0 + 4 + j <= t) ? w1[j] * Rv[s0 + 4 + j] : 0.f; }
            *(LAS u32x4*)(Wm + t * 136 + s0) = pack8(f); }
#pragma unroll
        for (int i = 0; i < 8; ++i) { const int pc = tid + 512 * i, s = pc >> 5, d0 = (pc & 31) * 8;
            const u32x4 v = *(const u32x4*)(V + (size_t)(tok0 + s) * 2048 + colb + d0);
            LAS unsigned* dst = (LAS unsigned*)(Vs + s * 258 + d0); dst[0] = v.x; dst[1] = v.y; dst[2] = v.z; dst[3] = v.w; }
        __syncthreads();
        f32x4 acc[8][2]; u32x2 upre[8][2];
#pragma unroll
        for (int mb = 0; mb < 8; ++mb) { acc[mb][0] = (f32x4){0.f, 0.f, 0.f, 0.f}; acc[mb][1] = (f32x4){0.f, 0.f, 0.f, 0.f};
#pragma unroll
            for (int nb = 0; nb < 2; ++nb) upre[mb][nb] = *(const u32x2*)(U + (size_t)(tok0 + mb * 16 + fr) * 2048 + colb + wave * 32 + nb * 16 + 4 * fq); }
#pragma unroll
        for (int kk = 0; kk < 4; ++kk) {
            bf16x8 vf[2];
#pragma unroll
            for (int nb = 0; nb < 2; ++nb) { const int d = wave * 32 + nb * 16 + fr;
#pragma unroll
                for (int j = 0; j < 8; ++j) vf[nb][j] = (short)Vs[(kk * 32 + fq * 8 + j) * 258 + d]; }
#pragma unroll
            for (int mb = 0; mb < 8; ++mb) { if (32 * kk <= 16 * mb + 15) {
                const bf16x8 wf = *(const LAS bf16x8*)(Wm + (mb * 16 + fr) * 136 + kk * 32 + fq * 8);
                acc[mb][0] = __builtin_amdgcn_mfma_f32_16x16x32_bf16(vf[0], wf, acc[mb][0], 0, 0, 0);
                acc[mb][1] = __builtin_amdgcn_mfma_f32_16x16x32_bf16(vf[1], wf, acc[mb][1], 0, 0, 0); } }
        }
#pragma unroll
        for (int mb = 0; mb < 8; ++mb) { const int t = mb * 16 + fr; const float bs = b_s[g * 128 + t];
#pragma unroll
            for (int nb = 0; nb < 2; ++nb) { const int col = colb + wave * 32 + nb * 16 + 4 * fq;
                const f32x4 gg = *(const f32x4*)(gv + col); bf16_t* up = U + (size_t)(tok0 + t) * 2048 + col;
                const u32x2 uw = upre[mb][nb];
                const float o0 = bf_lo(uw.x) * (acc[mb][nb][0] * gg[0] + bs), o1 = bf_hi(uw.x) * (acc[mb][nb][1] * gg[1] + bs), o2 = bf_lo(uw.y) * (acc[mb][nb][2] * gg[2] + bs), o3 = bf_hi(uw.y) * (acc[mb][nb][3] * gg[3] + bs);
                u32x2 ow; ow.x = cvt_pk_bf16(o0, o1); ow.y = cvt_pk_bf16(o2, o3); *(u32x2*)up = ow; } }
        __syncthreads();
    }
}

__device__ __forceinline__ void ffn_gate_phase(const bf16_t* Zc, bf16_t* A2, const float* cw, const float* cb, int gtid, int NT) {
    constexpr int NCG = FFW / 8; const int total = 8192 * NCG;
    for (int idx = gtid; idx < total; idx += NT) {
        const int lr = idx / NCG, cgp = idx - lr * NCG, c = cgp * 8, zc = (c >> 7) * 256 + (c & 127), tseq = lr & (SEQ - 1);
        float g[8], v[8];
        { const f32x4 a0 = *(const f32x4*)(cb + c), a1 = *(const f32x4*)(cb + c + 4), b0 = *(const f32x4*)(cb + FFW + c), b1 = *(const f32x4*)(cb + FFW + c + 4);
#pragma unroll
          for (int j = 0; j < 4; ++j) { g[j] = a0[j]; g[4 + j] = a1[j]; v[j] = b0[j]; v[4 + j] = b1[j]; } }
#pragma unroll
        for (int k = 0; k < 3; ++k) { const int dt = 2 - k; if (tseq >= dt) {
            const bf16_t* zp = Zc + (size_t)(lr - dt) * 5632 + zc; float zg[8], zv[8]; unpack8(*(const u32x4*)zp, zg); unpack8(*(const u32x4*)(zp + 128), zv);
            const f32x4 wg0 = *(const f32x4*)(cw + k * 5632 + c), wg1 = *(const f32x4*)(cw + k * 5632 + c + 4), wv0 = *(const f32x4*)(cw + k * 5632 + FFW + c), wv1 = *(const f32x4*)(cw + k * 5632 + FFW + c + 4);
#pragma unroll
            for (int j = 0; j < 4; ++j) { g[j] += wg0[j] * zg[j]; g[4 + j] += wg1[j] * zg[4 + j]; v[j] += wv0[j] * zv[j]; v[4 + j] += wv1[j] * zv[4 + j]; } } }
        float o[8];
#pragma unroll
        for (int j = 0; j < 8; ++j) o[j] = siluf_(g[j]) * v[j];
        *(u32x4*)(A2 + (size_t)lr * FFW + c) = pack8(o);
    }
}

__device__ __forceinline__ void scan1_phase(const unsigned* AB, float* Ls, float* Hs, int gtid, int NT) {
    for (int idx = gtid; idx < 8 * 64 * 512; idx += NT) {
        const int cp = idx & 511, j = (idx >> 9) & 63, b = idx >> 15, c = 2 * cp; const size_t row0 = (size_t)b * SEQ + j * 64;
        float h0 = 0.f, h1 = 0.f, L0 = 0.f, L1 = 0.f;
#pragma unroll 8
        for (int i = 0; i < 64; ++i) { const u32x2 w = *(const u32x2*)(AB + (row0 + i) * D + c);
            const float la0 = f16_lo(w.x), la1 = f16_lo(w.y); h0 = __expf(la0) * h0 + f16_hi(w.x); h1 = __expf(la1) * h1 + f16_hi(w.y); L0 += la0; L1 += la1; }
        const size_t o = ((size_t)b * 64 + j) * 1024 + c; Ls[o] = L0; Ls[o + 1] = L1; Hs[o] = h0; Hs[o + 1] = h1;
    }
}
__device__ __forceinline__ void scan2_phase(const unsigned* AB, const float* Ls, const float* Hs, const bf16_t* G, bf16_t* Y, int gtid, int NT) {
    for (int idx = gtid; idx < 8 * 64 * 256; idx += NT) {
        const int cq = idx & 255, j = (idx >> 8) & 63, b = idx >> 14, c = 4 * cq; const size_t row0 = (size_t)b * SEQ + j * 64;
        f32x4 h = (f32x4){0.f, 0.f, 0.f, 0.f};
#pragma unroll 8
        for (int jj = 0; jj < j; ++jj) { const size_t o = ((size_t)b * 64 + jj) * 1024 + c; const f32x4 l = *(const f32x4*)(Ls + o), hh = *(const f32x4*)(Hs + o);
#pragma unroll
            for (int k = 0; k < 4; ++k) h[k] = __expf(l[k]) * h[k] + hh[k]; }
#pragma unroll
        for (int b4 = 0; b4 < 4; ++b4) {
            u32x4 w[16]; u32x2 gq[16];
#pragma unroll
            for (int i = 0; i < 16; ++i) { const size_t off = (row0 + b4 * 16 + i) * D + c; w[i] = *(const u32x4*)(AB + off); gq[i] = *(const u32x2*)(G + off); }
#pragma unroll
            for (int i = 0; i < 16; ++i) {
#pragma unroll
                for (int k = 0; k < 4; ++k) h[k] = __expf(f16_lo(w[i][k])) * h[k] + f16_hi(w[i][k]);
                u32x2 yo; yo.x = cvt_pk_bf16(h[0] * bf_lo(gq[i].x), h[1] * bf_hi(gq[i].x)); yo.y = cvt_pk_bf16(h[2] * bf_lo(gq[i].y), h[3] * bf_hi(gq[i].y));
                *(u32x2*)(Y + (row0 + b4 * 16 + i) * D + c) = yo; }
        }
    }
}

__device__ __forceinline__ void final_norm_phase(float* out, const bf16_t* xb, const float* ss, const float* g, const int tid, const int bx) {
    const int lane = tid & 63, gw = bx * 8 + (tid >> 6), NGW = gridDim.x * 8;
    const f32x4* gr = (const f32x4*)g + 2 * lane;
    const f32x4 g00 = gr[0], g01 = gr[1], g10 = gr[128], g11 = gr[129];
    for (int rowq = gw; rowq < M / 4; rowq += NGW) {
        float rs[4]; u32x4 xv[4][2];
#pragma unroll
        for (int q = 0; q < 4; ++q) { const int row = rowq * 4 + q; rs[q] = sum16(ss + (size_t)row * 16); const u32x4* xr = (const u32x4*)(xb + (size_t)row * D) + lane; xv[q][0] = xr[0]; xv[q][1] = xr[64]; }
#pragma unroll
        for (int q = 0; q < 4; ++q) { const int row = rowq * 4 + q; const float r = rsqrtf(rs[q] * (1.0f / 1024.0f) + EPS); f32x4* o = (f32x4*)(out + (size_t)row * D) + 2 * lane;
            float xf[8]; unpack8(xv[q][0], xf); o[0] = (f32x4){xf[0], xf[1], xf[2], xf[3]} * r * g00; o[1] = (f32x4){xf[4], xf[5], xf[6], xf[7]} * r * g01;
            unpack8(xv[q][1], xf); o[128] = (f32x4){xf[0], xf[1], xf[2], xf[3]} * r * g10; o[129] = (f32x4){xf[4], xf[5], xf[6], xf[7]} * r * g11; }
    }
}

#define XB_TMO      128
#define XB_XCNT(j)  (256  + 64 * (j))
#define XB_XSUB(j)  (1280 + 64 * (j))
#define XB_XGEN(j)  (2304 + 64 * (j))
#define XB_TOP      3328
#define XB_TOPGEN   3392
#define XCD_BAR_WORDS 3456
#define XB_SPIN_CAP (1u << 20)
__device__ __forceinline__ unsigned xb_ld(unsigned* p)              { return __hip_atomic_load(p, __ATOMIC_RELAXED, __HIP_MEMORY_SCOPE_AGENT); }
__device__ __forceinline__ unsigned xb_add(unsigned* p, unsigned v) { return __hip_atomic_fetch_add(p, v, __ATOMIC_RELAXED, __HIP_MEMORY_SCOPE_AGENT); }
__device__ __forceinline__ unsigned xb_xcc_id() { return (unsigned)__builtin_amdgcn_s_getreg((3 << 11) | 20) & 0xFu; }
#define XB_SPIN(cond, bar) do { unsigned _sp = 0; while (cond) { __builtin_amdgcn_s_sleep(1); \
    if ((++_sp & 255u) == 0u) { if (xb_ld(&(bar)[XB_TMO])) break; if (_sp > XB_SPIN_CAP) { atomicAdd(&(bar)[XB_TMO], 1u); break; } } } } while (0)
__device__ __forceinline__ void xcd_barrier_complete(unsigned* bar, unsigned x, unsigned& nloc, unsigned& nx) {
    const unsigned G = gridDim.x * gridDim.y * gridDim.z;
    unsigned sum, cnt, mine, sp = 0u;
    for (;;) {
        sum = 0u; cnt = 0u; mine = 0u;
#pragma unroll
        for (unsigned j = 0; j < 16; ++j) { const unsigned c = xb_ld(&bar[XB_XCNT(j)]); sum += c; cnt += (c > 0u) ? 1u : 0u; mine = (j == x) ? c : mine; }
        if (sum == G) break;
        __builtin_amdgcn_s_sleep(1);
        if ((++sp & 255u) == 0u) { if (xb_ld(&bar[XB_TMO])) break; if (sp > XB_SPIN_CAP) { atomicAdd(&bar[XB_TMO], 1u); break; } }
    }
    nloc = mine > 0u ? mine : 1u; nx = cnt > 0u ? cnt : 1u;
}
__device__ __forceinline__ void xcd_barrier(unsigned* bar, volatile LAS unsigned* st, const bool leader) {
    asm volatile("s_waitcnt vmcnt(0)" ::: "memory");
    __syncthreads();
    if (leader) {
        const unsigned x = xb_xcc_id();
        __builtin_amdgcn_s_waitcnt(0);
        unsigned nloc = st[0], nx = st[1];
        if (nloc == 0u) { xcd_barrier_complete(bar, x, nloc, nx); st[0] = nloc; st[1] = nx; }
        const unsigned old = xb_add(&bar[XB_XSUB(x)], 1u);
        const unsigned gen = old / nloc;
        if (old + 1u == (gen + 1u) * nloc) {
            __builtin_amdgcn_fence(__ATOMIC_RELEASE, "agent");
            asm volatile("s_waitcnt vmcnt(0)" ::: "memory");
            const unsigned og = xb_add(&bar[XB_TOP], 1u);
            const unsigned tg = og / nx;
            if (og + 1u == (tg + 1u) * nx) xb_add(&bar[XB_TOPGEN], 1u);
            else XB_SPIN(xb_ld(&bar[XB_TOPGEN]) == tg, bar);
            __builtin_amdgcn_fence(__ATOMIC_ACQUIRE, "agent");
            xb_add(&bar[XB_XGEN(x)], 1u);
            asm volatile("s_waitcnt vmcnt(0)" ::: "memory");
        } else {
            XB_SPIN(xb_ld(&bar[XB_XGEN(x)]) == gen, bar);
            __builtin_amdgcn_fence(__ATOMIC_ACQUIRE, "agent");
            asm volatile("s_waitcnt vmcnt(0)" ::: "memory");
        }
    }
    __syncthreads();
}

#ifndef KINDS
#define KINDS 31
#endif
enum { K_PROLOGUE = 0, K_GEMM_FFN, K_GEMM_Z, K_GEMM_RES, K_GEMM_GATE, K_GMLP, K_FFNGATE, K_POOL, K_CONV4, K_SCAN1, K_SCAN2, K_SHORTCONV, K_FINAL };
constexpr int NPHASES = 1 + 3 + 2 + 3 + 2 + 4 + 2 + 2 + 2;

__global__ void __launch_bounds__(NTHREADS) mega_fwd(Params p) {
    extern __shared__ __attribute__((aligned(16))) unsigned char lds_raw[];
    LAS unsigned char* lds = (LAS unsigned char*)lds_raw;
    cg::grid_group grid = cg::this_grid();
    const int NT = gridDim.x * NTHREADS, G = gridDim.x;
    const int wid_s = __builtin_amdgcn_readfirstlane((int)threadIdx.x >> 6);
    volatile LAS unsigned* bst = (volatile LAS unsigned*)(lds + 131072 + 512);
    if (threadIdx.x == 0) { bst[0] = 0u; bst[1] = 0u; (void)xb_add(&((unsigned*)(p.ws + WS_BAR))[XB_XCNT(xb_xcc_id())], 1u); }
    __syncthreads();
#define SSK(k) (SS + (size_t)(k) * M * 16)

#ifndef PROBE_PH
#define PROBE_PH 1000
#endif
#ifndef PROBE_REPS
#define PROBE_REPS 0
#endif
    for (int phx = 0; phx < NPHASES + PROBE_REPS; ++phx) {
        const int ph = (phx <= PROBE_PH) ? phx : ((phx - PROBE_PH <= PROBE_REPS) ? PROBE_PH : phx - PROBE_REPS);
        int tid = wid_s * 64 + lane_id_hw(); asm volatile("" : "+v"(tid));
        int bx = blockIdx.x; asm volatile("" : "+s"(bx));
        unsigned char* ws = p.ws; asm volatile("" : "+s"(ws));
        float* X = p.out; asm volatile("" : "+s"(X));
        const int gtid = bx * NTHREADS + tid;
        float* SS = (float*)(ws + WS_SS);
        bf16_t* WB = (bf16_t*)(ws + WS_W);
        bf16_t* xb = (bf16_t*)(ws + WS_XB);
        unsigned char* AR = ws + WS_ARENA;
        int seg, q = ph;
        if (q == 0) seg = 0;
        else if ((q -= 1) < 3) seg = 1;
        else if ((q -= 3) < 2) seg = 8;
        else if ((q -= 2) < 3) seg = 2;
        else if ((q -= 3) < 2) seg = 9;
        else if ((q -= 2) < 4) seg = 3;
        else if ((q -= 4) < 2) seg = 10;
        else if ((q -= 2) < 2) seg = 4;
        else if ((q -= 2) < 2) seg = 11;
        else seg = 5;
        int kind;
        if (seg == 0) kind = K_PROLOGUE;
        else if (seg == 1) kind = (q == 0) ? K_GEMM_Z : (q == 1) ? K_GMLP : K_GEMM_RES;
        else if (seg == 2) kind = (q == 0) ? K_GEMM_Z : (q == 1) ? K_GEMM_Z : K_GEMM_RES;
        else if (seg == 3) kind = (q == 0) ? K_GEMM_Z : (q == 1) ? K_GEMM_GATE : (q == 2) ? K_SCAN2 : K_GEMM_RES;
        else if (seg == 4) kind = (q == 0) ? K_GEMM_Z : K_GEMM_RES;
        else if (seg == 5) kind = K_FINAL;
        else kind = (q == 0) ? K_GEMM_FFN : K_GEMM_RES;
        const int fl = seg - 8;

        if (kind == K_PROLOGUE) prologue_phase(p, lds, tid, bx);
        else if (kind == K_GEMM_FFN) {
            pg8::Gemm g{xb, WB + O_F + fl * (F_UP_SZ + F_DN_SZ), D, D, 128, 22, 0, 0};
            pg8::EpiFfn ef{(bf16_t*)AR, SSK(2 * fl + 1), p.in[31] + (size_t)fl * 3 * 5632, p.in[32] + (size_t)fl * 5632, (float*)(AR + 176 * MiB), (LAS float*)(lds + 131072 + 1024)};
            pg8::StaticOrder S; S.init(128, 22, G, bx, FFN_WGM);
            pg8::gemm_phase(lds, g, S, ef, tid);
        }
#if KINDS & 1
        else if (kind == K_GEMM_Z) {
            size_t a_off = WS_XB, w_off = 0, o_off = WS_ARENA, split_stride = 0; int lda = D, K = D, nM = 128, nN = 4, astep = 0, ldc = D, bias_i = -1, split_cols = 0, ss_k = -1, ss_row = 0, act_pn = 0, ssv_on = 0, post = 0;
            if (seg == 1) { w_off = O_A_IN; nN = 16; ldc = 2048; bias_i = 3; split_cols = 2048; split_stride = (size_t)64 * MiB; ss_k = 0; act_pn = 16; ssv_on = 1; }
            else if (seg == 2 && q == 0) { w_off = O_B_IN; ss_k = 2; post = 3; }
            else if (seg == 2) { a_off = WS_ARENA + 64 * MiB; w_off = O_B_GRP; K = 256; astep = 256; o_off = WS_ARENA + 128 * MiB; bias_i = 11; }
            else if (seg == 3) { w_off = O_C_IN; nN = 8; bias_i = 16; split_cols = 1024; split_stride = (size_t)32 * MiB; ss_k = 4; act_pn = 4; post = 2; }
            else { w_off = O_D_IN; nN = 12; ldc = 3072; ss_k = 6; post = 1; }
            pg8::Gemm g{(const bf16_t*)(ws + a_off), WB + w_off, lda, K, nM, nN, 0, astep};
            pg8::EpiZ ez{(bf16_t*)(ws + o_off), ldc, bias_i >= 0 ? p.in[bias_i] : nullptr, split_cols, split_stride, ss_k >= 0 ? SSK(ss_k) + (size_t)ss_row * 16 : nullptr, act_pn, ssv_on ? (float*)(ws + WS_SSV) : nullptr, 8, (LAS float*)(lds + 131072 + 1024 + 6144),
                         post, post == 2 ? (const bf16_t*)(AR + 64 * MiB) : (const bf16_t*)AR, post == 1 ? (bf16_t*)(AR + 192 * MiB) : post == 2 ? (bf16_t*)(AR + 128 * MiB) : (bf16_t*)(AR + 64 * MiB), post == 1 ? p.in[27] : p.in[17], p.in[18]};
            pg8::StaticOrder S; S.init(nM, nN, G, bx);
            if (seg == 2 && q == 1) {
                pg8::Unit uu;
                for (int i = 0; S.next(i, uu); ++i) { if ((uu.pm & 15) == 0) continue;
                    const int win = 2 << uu.pn, r = tid >> 5;
                    if (r < win - 1) pool_item((const bf16_t*)AR, (bf16_t*)(AR + 64 * MiB), uu.pm * 256 + r, uu.pn * 256 + (tid & 31) * 8, win, (uu.pm * 256 + r) & (SEQ - 1)); }
                asm volatile("s_waitcnt vmcnt(0)" ::: "memory"); __syncthreads();
            }
            pg8::gemm_phase(lds, g, S, ez, tid);
        }
#endif
#if KINDS & 2
        else if (kind == K_GEMM_RES) {
            size_t a_off = WS_ARENA, w_off = O_A_OUT; int K = D, ssn = 1;
            if (seg == 1) { K = 2048; }
            else if (seg == 2) { a_off = WS_ARENA + 128 * MiB; w_off = O_B_OUT; ssn = 3; }
            else if (seg == 3) { a_off = WS_ARENA + 64 * MiB; w_off = O_C_OUT; ssn = 5; }
            else if (seg == 4) { a_off = WS_ARENA + 192 * MiB; w_off = O_D_OUT; ssn = 7; }
            else { a_off = WS_ARENA; w_off = O_F + fl * (F_UP_SZ + F_DN_SZ) + F_UP_SZ; K = FFW; ssn = 2 * fl + 2; }
            pg8::Gemm g{(const bf16_t*)(ws + a_off), WB + w_off, K, K, 128, 4, 0, 0};
            pg8::EpiRes er{xb, SSK(ssn)};
            pg8::StaticOrder S; S.init(128, 4, G, bx);
            if (seg == 4) {
                pg8::Unit uu;
                for (int i = 0; S.next(i, uu); ++i) { if ((uu.pm & 15) == 0) continue;
                    if (tid < 256) shortconv_item((const bf16_t*)AR, (bf16_t*)(AR + 192 * MiB), p.in[27], uu.pm * 256 + (tid >> 7), (tid & 127) * 8, 2); }
                asm volatile("s_waitcnt vmcnt(0)" ::: "memory"); __syncthreads();
            }
            if (seg >= 8) {
                const float* ZS = (const float*)(AR + 176 * MiB); bf16_t* A2 = (bf16_t*)AR; const float* cw = p.in[31] + (size_t)fl * 3 * 5632; const float* cb = p.in[32] + (size_t)fl * 5632;
                pg8::Unit uu;
                for (int i = 0; S.next(i, uu); ++i) { if ((uu.pm & 15) == 0) continue;
                    for (int idx = tid; idx < 2 * 704; idx += NTHREADS) { const int r = idx / 704, c = (idx - r * 704) * 4;
                        f32x4 gsum = *(const f32x4*)(cb + c), vsum = *(const f32x4*)(cb + FFW + c);
#pragma unroll
                        for (int k = 0; k < 3; ++k) { const int j = r - 2 + k; const float* zr = (j < 0) ? ZS + ((size_t)(uu.pm - 1) * 4 + 4 + j) * 5632 : ZS + ((size_t)uu.pm * 4 + j) * 5632;
                            gsum += *(const f32x4*)(cw + k * 5632 + c) * *(const f32x4*)(zr + c); vsum += *(const f32x4*)(cw + k * 5632 + FFW + c) * *(const f32x4*)(zr + FFW + c); }
                        u32x2 w; w.x = cvt_pk_bf16(siluf_(gsum[0]) * vsum[0], siluf_(gsum[1]) * vsum[1]); w.y = cvt_pk_bf16(siluf_(gsum[2]) * vsum[2], siluf_(gsum[3]) * vsum[3]);
                        *(u32x2*)(A2 + (size_t)(uu.pm * 256 + r) * FFW + c) = w; } }
                asm volatile("s_waitcnt vmcnt(0)" ::: "memory"); __syncthreads();
            }
            if (seg == 11) {
                pg8::EpiResFinal ef{xb, SSK(8), (unsigned*)(ws + WS_BAR) + 3584, X, p.in[34], (LAS float*)(lds + 131072 + 1024 + 6144)};
                pg8::gemm_phase(lds, g, S, ef, tid);
            } else
            pg8::gemm_phase(lds, g, S, er, tid);
        }
#endif
#if KINDS & 4
        else if (kind == K_GEMM_GATE) {
            pg8::Gemm g{(bf16_t*)(AR + 128 * MiB), WB + O_C_GATE, D, 256, 128, 8, 1, 256};
            pg8::EpiGate eg{(const bf16_t*)(AR + 128 * MiB), p.in[20], p.in[22], p.in[23], (unsigned*)(AR + 192 * MiB), (float*)(ws + WS_SCAN), (float*)(ws + WS_SCAN) + 8 * 64 * 1024};
            pg8::StaticOrder S; S.init(g.nM, g.nN, G, bx);
            {
                pg8::Unit uu;
                for (int i = 0; S.next(i, uu); ++i) { if ((uu.pm & 15) == 0) continue;
                    if (tid < 96) conv4_item((const bf16_t*)(AR + 64 * MiB), (bf16_t*)(AR + 128 * MiB), p.in[17], p.in[18], uu.pm * 256 + (tid >> 5), (uu.pn >> 1) * 256 + (tid & 31) * 8, 3); }
                asm volatile("s_waitcnt vmcnt(0)" ::: "memory"); __syncthreads();
            }
            pg8::gemm_phase(lds, g, S, eg, tid);
        }
#endif
#if KINDS & 8
        else if (kind == K_GMLP) gmlp_gate_phase(p, lds, (bf16_t*)AR, (const bf16_t*)(AR + 128 * MiB), (const float*)(ws + WS_SSV), tid, bx);
#endif
#if KINDS & 16
        else if (kind == K_SCAN2) scan2_phase((const unsigned*)(AR + 192 * MiB), (const float*)(ws + WS_SCAN), (const float*)(ws + WS_SCAN) + 8 * 64 * 1024, (const bf16_t*)AR, (bf16_t*)(AR + 64 * MiB), gtid, NT);
#endif
        if (wid_s == 0 && lane_id_hw() == 0) { *(volatile LAS int*)(lds + 131072 + 1024 + 6144 + 1024) = -1; *(volatile LAS int*)(lds + 131072 + 1024 + 6144 + 1024 + 64) = -1; *(volatile LAS int*)(lds + 131072 + 1024 + 6144 + 1024 + 68) = -1; }
        if (p.out == nullptr) { asm volatile("s_waitcnt vmcnt(0)" ::: "memory"); grid.sync(); }
        else if (phx + 1 < NPHASES + PROBE_REPS) xcd_barrier((unsigned*)(p.ws + WS_BAR), bst, wid_s == 0 && lane_id_hw() == 0);
    }
}

extern "C" void kernel_launch(void* const* d_in, const int* in_sizes, int n_in, void* d_out, int out_size, void* d_ws, size_t ws_size, hipStream_t stream) {
    static int grid = 0;
    if (grid == 0) {
        if (n_in != 35 || out_size != M * D || ws_size < WS_NEED) { fprintf(stderr, "kernel_launch: unexpected shapes: n_in %d out %d ws %zu\n", n_in, out_size, ws_size); grid = -1; return; }
        int dev = 0, cus = 0, per_cu = 0;
        (void)hipGetDevice(&dev); (void)hipDeviceGetAttribute(&cus, hipDeviceAttributeMultiprocessorCount, dev);
        if (hipFuncSetAttribute((const void*)mega_fwd, hipFuncAttributeMaxDynamicSharedMemorySize, LDS_BYTES) != hipSuccess) { fprintf(stderr, "kernel_launch: hipFuncSetAttribute failed\n"); grid = -1; return; }
        if (hipOccupancyMaxActiveBlocksPerMultiprocessor(&per_cu, (const void*)mega_fwd, NTHREADS, LDS_BYTES) != hipSuccess || per_cu < 1) { fprintf(stderr, "kernel_launch: occupancy query says %d\n", per_cu); per_cu = 1; }
        (void)hipGetLastError();
        grid = cus;
        if (cus != 256) { fprintf(stderr, "kernel_launch: built for a 256-CU device (fused conv stages rely on the 256-workgroup unit order), found %d\n", cus); grid = -1; return; }
        fprintf(stderr, "kernel_launch: grid %d (per_cu %d)\n", grid, per_cu);
    }
    if (grid < 0) return;
    if (hipMemsetAsync((char*)d_ws + WS_BAR, 0, 16384, stream) != hipSuccess) { fprintf(stderr, "kernel_launch: memset failed\n"); return; }
    Params p{};
    for (int i = 0; i < 35; ++i) p.in[i] = (const float*)d_in[i];
    p.out = (float*)d_out; p.ws = (unsigned char*)d_ws;
    void* args[] = {&p};
    hipError_t e = hipLaunchCooperativeKernel((const void*)mega_fwd, dim3(grid), dim3(NTHREADS), args, LDS_BYTES, stream);
    if (e != hipSuccess) fprintf(stderr, "kernel_launch: cooperative launch failed: %s\n", hipGetErrorString(e));
}
```
